# Optimizing an MI355X kernel written in HIP

```python
import jax, jax.numpy as jnp
from jax import lax
import numpy as np

D_MODEL = 1024
BATCH = 8
SEQ = 4096
DEPTH = 1

D_MIX = D_MODEL
D_A = D_MIX // 2
D_B = D_MIX - D_A
HEAD_A = 64
G_A = D_A // HEAD_A
HEAD_B = 64
H_B = D_B // HEAD_B
CHUNK = 128
DECAY_RANK = 64
ICLR_RANK = 64
LN_EPS = 1e-5
GN_EPS = 64e-5
ALPHA = (2 * DEPTH) ** 0.25
BETA = (8 * DEPTH) ** -0.25

N_COLS_A = 3 * D_A
N_COLS_B = 4 * D_B + DECAY_RANK + ICLR_RANK
N_COLS = N_COLS_A + N_COLS_B

kernel_name = "hybrid_gmlp_rwkv7_deepnorm_adaln"


def _layer_norm(x, g, b, eps):
    xf = x.astype(jnp.float32)
    mu = jnp.mean(xf, axis=-1, keepdims=True)
    var = jnp.mean(jnp.square(xf - mu), axis=-1, keepdims=True)
    y = (xf - mu) * lax.rsqrt(var + eps)
    return (y * g.astype(jnp.float32) + b.astype(jnp.float32)).astype(x.dtype)


def _token_shift(p, mu):
    prev = jnp.pad(p, ((0, 0), (1, 0), (0, 0)))[:, :-1]
    return p + mu * (prev - p)


def _rwkv7_scan(r, w, k, v, a, b):
    Bsz, T, H, N = r.shape
    seq_first = lambda z: jnp.swapaxes(z, 0, 1)
    xs = tuple(seq_first(z) for z in (r, w, k, v, a, b))

    def step(S, inp):
        r_t, w_t, k_t, v_t, a_t, b_t = inp
        sa = jnp.einsum('bhij,bhj->bhi', S, a_t)
        S = S * w_t[:, :, None, :] + sa[..., None] * b_t[:, :, None, :] + v_t[..., None] * k_t[:, :, None, :]
        y = jnp.einsum('bhij,bhj->bhi', S, r_t)
        return S, y

    S0 = jnp.zeros((Bsz, H, N, N), jnp.float32)
    _, ys = lax.scan(step, S0, xs)
    return jnp.swapaxes(ys, 0, 1)


def _gmlp_branch(p_a, ln_v_g, ln_v_b, w_spatial, b_spatial):
    Bsz, T, _ = p_a.shape
    u = jax.nn.gelu(p_a[..., :D_A])
    v = jax.nn.gelu(p_a[..., D_A:2 * D_A])
    gate = p_a[..., 2 * D_A:]
    v = v.reshape(Bsz, T, G_A, HEAD_A)
    v = _layer_norm(v, ln_v_g, ln_v_b, LN_EPS)
    v = v.reshape(Bsz, T // CHUNK, CHUNK, G_A, HEAD_A)
    causal = jnp.tril(jnp.ones((CHUNK, CHUNK), dtype=bool))
    w_m = jnp.where(causal[None], w_spatial, jnp.zeros((), w_spatial.dtype))
    v = jnp.einsum('gts,bcsgd->bctgd', w_m, v) + jnp.swapaxes(b_spatial, 0, 1)[None, None, :, :, None]
    v = v.reshape(Bsz, T, D_A)
    return u * v * jax.nn.silu(gate)


def _rwkv7_branch(p_b, mu_b, w0, w_up, a0, a_up, k_k, k_a, r_k, gn_g, gn_b):
    Bsz, T, _ = p_b.shape
    p_b = _token_shift(p_b, mu_b)
    o = 0
    r = p_b[..., o:o + D_B]; o += D_B
    k = p_b[..., o:o + D_B]; o += D_B
    v = p_b[..., o:o + D_B]; o += D_B
    gate = p_b[..., o:o + D_B]; o += D_B
    wd = p_b[..., o:o + DECAY_RANK]; o += DECAY_RANK
    ad = p_b[..., o:o + ICLR_RANK]

    w_raw = -jax.nn.softplus(-(w0 + jnp.tanh(wd) @ w_up)) - 0.5
    a = jax.nn.sigmoid(a0 + ad @ a_up)

    heads = lambda z: z.reshape(Bsz, T, H_B, HEAD_B).astype(jnp.float32)
    kk = heads(k * k_k)
    kk = kk * lax.rsqrt(jnp.sum(kk * kk, axis=-1, keepdims=True) + 1e-12)
    k = k * (1 + (a - 1) * k_a)
    rh, kh, vh, ah = heads(r), heads(k), heads(v), heads(a)
    decay = jnp.exp(-jnp.exp(heads(w_raw)))

    y = _rwkv7_scan(rh, decay, kh, vh, -kk, kk * ah)
    y = _layer_norm(y, gn_g, gn_b, GN_EPS)
    bonus = jnp.sum(rh * kh * r_k.astype(jnp.float32), axis=-1, keepdims=True) * vh
    y = (y + bonus).reshape(Bsz, T, D_B).astype(p_b.dtype)
    return y * jax.nn.silu(gate)


def setup_inputs(seed: int = 0) -> dict:
    key = jax.random.key(seed)
    ks = jax.random.split(key, 24)
    f32 = jnp.float32
    nrm = lambda k, s, sc: jax.random.normal(k, s, f32) * sc
    return {
        "x": nrm(ks[0], (BATCH, SEQ, D_MODEL), 1.0),
        "c": nrm(ks[1], (BATCH, D_MODEL), 1.0),
        "w_ada": nrm(ks[2], (D_MODEL, 3 * D_MODEL), D_MODEL ** -0.5),
        "b_ada": nrm(ks[3], (3 * D_MODEL,), 0.02),
        "w_in": nrm(ks[4], (D_MODEL, N_COLS), D_MODEL ** -0.5),
        "mu_b": jax.random.uniform(ks[5], (N_COLS_B,), f32),
        "ln_v_g": 1.0 + nrm(ks[6], (G_A, HEAD_A), 0.05),
        "ln_v_b": nrm(ks[7], (G_A, HEAD_A), 0.02),
        "w_spatial": nrm(ks[8], (G_A, CHUNK, CHUNK), CHUNK ** -0.5),
        "b_spatial": 1.0 + nrm(ks[9], (G_A, CHUNK), 0.1),
        "w0": jax.random.uniform(ks[10], (D_B,), f32, -4.0, 1.0),
        "w_up": nrm(ks[11], (DECAY_RANK, D_B), 0.5 * DECAY_RANK ** -0.5),
        "a0": nrm(ks[12], (D_B,), 0.5),
        "a_up": nrm(ks[13], (ICLR_RANK, D_B), 0.5 * ICLR_RANK ** -0.5),
        "k_k": 0.85 + nrm(ks[14], (D_B,), 0.05),
        "k_a": 1.0 + nrm(ks[15], (D_B,), 0.05),
        "r_k": nrm(ks[16], (H_B, HEAD_B), 0.1),
        "gn_g": 1.0 + nrm(ks[17], (H_B, HEAD_B), 0.05),
        "gn_b": nrm(ks[18], (H_B, HEAD_B), 0.02),
        "w_out": nrm(ks[19], (D_MIX, D_MODEL), BETA * D_MIX ** -0.5),
        "ln_g": 1.0 + nrm(ks[20], (D_MODEL,), 0.05),
        "ln_b": nrm(ks[21], (D_MODEL,), 0.02),
    }


def reference(x, c, w_ada, b_ada, w_in, mu_b, ln_v_g, ln_v_b, w_spatial, b_spatial,
              w0, w_up, a0, a_up, k_k, k_a, r_k, gn_g, gn_b, w_out, ln_g, ln_b):
    mod = jax.nn.silu(c) @ w_ada + b_ada
    shift, scale, gate = [m[:, None, :] for m in jnp.split(mod, 3, axis=-1)]
    for _ in range(DEPTH):
        h = x * (1 + scale) + shift
        p = h @ w_in
        out_a = _gmlp_branch(p[..., :N_COLS_A], ln_v_g, ln_v_b, w_spatial, b_spatial)
        out_b = _rwkv7_branch(p[..., N_COLS_A:], mu_b, w0, w_up, a0, a_up, k_k, k_a, r_k, gn_g, gn_b)
        o = jnp.concatenate([out_a, out_b], axis=-1) @ w_out
        x = _layer_norm(ALPHA * x + gate * o, ln_g, ln_b, LN_EPS)
    return x
```

```cpp
#include <hip/hip_runtime.h>
#include <hip/hip_cooperative_groups.h>
#include <cstdio>
namespace cg = cooperative_groups;
namespace pg8 {
#define PG8_LAS __attribute__((address_space(3)))
typedef unsigned short bf16_t;
typedef short bf16x8 __attribute__((ext_vector_type(8)));
typedef float f32x4 __attribute__((ext_vector_type(4)));
typedef unsigned u32x4 __attribute__((ext_vector_type(4)));
constexpr int BM = 256, BK = 64, HALF = 128, HTB = HALF * BK * 2  , STAGE_BYTES = 8 * HTB, NXCD = 8, WGM = 8;

__host__ __device__ __forceinline__ int lds_byte(int r, int c) { const int st = (r >> 4) * 2 + (c >> 5), rr = r & 15, cc = c & 31, ob = rr * 64 + cc * 2; return st * 1024 + (ob ^ (((ob >> 9) & 1) << 5)); }
__host__ __device__ __forceinline__ void stage_rc(int b, int& R, int& C) { const int st = b / 1024, sb = b % 1024, swz = sb ^ (((sb >> 9) & 1) << 5); R = (st >> 1) * 16 + swz / 64; C = (st & 1) * 32 + (swz % 64) / 2; }
__host__ __device__ __forceinline__ int perm32(int rho) { const int n = rho >> 4, i = rho & 15; return 8 * (i >> 2) + 4 * n + (i & 3); }

struct Unit { int pm, pn; };
struct Gemm { const bf16_t* A; const bf16_t* Bt; int M, N, K; };

struct StaticOrder {
    int nM, nN, nwg, G, c;
    __host__ __device__ void init(int M, int N, int G_, int c_) { nM = M / BM; nN = N / BM; nwg = nM * nN; G = G_; c = c_; }
    __host__ __device__ bool next(int i, Unit& u) const {
        const long L = (long)i * G + c; if (L >= nwg) return false;
        int wgid = (int)L; { const int q = nwg / NXCD, r = nwg % NXCD, xcd = wgid % NXCD, off = wgid / NXCD; wgid = (xcd < r ? xcd * (q + 1) : r * (q + 1) + (xcd - r) * q) + off; }
        const int nig = WGM * nN, gid = wgid / nig, fm = gid * WGM, gsz = (nM - fm) < WGM ? (nM - fm) : WGM;
        u.pm = fm + ((wgid % nig) % gsz); u.pn = (wgid % nig) / gsz; return true;
    }
    __device__ __forceinline__ void a_ready(const Unit&) const {}
    __device__ __forceinline__ void done(const Unit&) const {}
};

__device__ __forceinline__ unsigned cvt_pk_bf16(float lo, float hi) { unsigned r; asm volatile("v_cvt_pk_bf16_f32 %0, %1, %2" : "=v"(r) : "v"(lo), "v"(hi)); return r; }
typedef float f32x2 __attribute__((ext_vector_type(2)));
__device__ __forceinline__ f32x2 gelu_pk(f32x2 v) {
    const f32x2 av = __builtin_elementwise_abs(v), d = av * 0.2316418882f + 1.0f;
    f32x2 t; t.x = __builtin_amdgcn_rcpf(d.x); t.y = __builtin_amdgcn_rcpf(d.y);
    f32x2 q = t * 0.5307027145f + (-0.7265760135f); q = q * t + 0.7107068705f; q = q * t + (-0.142248368f); q = q * t + 0.127414796f; q = q * t;
    const f32x2 s = (v * v) * (-0.72134752044f);
    f32x2 e; e.x = __builtin_amdgcn_exp2f(s.x); e.y = __builtin_amdgcn_exp2f(s.y);
    const f32x2 m = v * (q * e), r = v - m;
    f32x2 o; o.x = v.x < 0.f ? m.x : r.x; o.y = v.y < 0.f ? m.y : r.y; return o;
}

struct EpiF32 {
    static constexpr bool PERM = false, AFTER_DRAIN = false;
    float* C; int ldc; const float* bias;
    __device__ __forceinline__ void operator()(const f32x4 (&acc)[2][2][4][2], const Unit& u, int wr, int wc, int fr, int fq) const {
        const int row0 = u.pm * BM + wr * 64 + fr, col0 = u.pn * BM + wc * 32 + 4 * fq;
        f32x4 bv[2][2];
#pragma unroll
        for (int bj = 0; bj < 2; ++bj)
#pragma unroll
            for (int n = 0; n < 2; ++n) bv[bj][n] = bias ? *(const f32x4*)(bias + col0 + bj * HALF + n * 16) : (f32x4){0.f, 0.f, 0.f, 0.f};
#pragma unroll
        for (int ai = 0; ai < 2; ++ai)
#pragma unroll
            for (int m = 0; m < 4; ++m) { float* rowp = C + (size_t)(row0 + ai * HALF + m * 16) * ldc + col0;
#pragma unroll
                for (int bj = 0; bj < 2; ++bj)
#pragma unroll
                    for (int n = 0; n < 2; ++n) *(f32x4*)(rowp + bj * HALF + n * 16) = acc[ai][bj][m][n] + bv[bj][n]; }
    }
};
template <int ACT  > struct EpiBf16 {
    static constexpr bool PERM = true, AFTER_DRAIN = false;
    bf16_t* O; int ldc; const float* bias; int split_cols; size_t split_stride;
    __device__ __forceinline__ void operator()(const f32x4 (&acc)[2][2][4][2], const Unit& u, int wr, int wc, int fr, int fq) const {
        const int row0 = u.pm * BM + wr * 64 + fr; int colt = u.pn * BM; bf16_t* base = O;
        if (split_cols) { const int t = colt / split_cols; base += (size_t)t * split_stride; colt -= t * split_cols; }
        const int col0 = colt + wc * 32 + 8 * fq, bcol0 = u.pn * BM + wc * 32 + 8 * fq;
        f32x4 bv[2][2];
#pragma unroll
        for (int bj = 0; bj < 2; ++bj)
#pragma unroll
            for (int n = 0; n < 2; ++n) bv[bj][n] = bias ? *(const f32x4*)(bias + bcol0 + bj * HALF + 4 * n) : (f32x4){0.f, 0.f, 0.f, 0.f};
#pragma unroll
        for (int ai = 0; ai < 2; ++ai)
#pragma unroll
            for (int m = 0; m < 4; ++m) { bf16_t* rowp = base + (size_t)(row0 + ai * HALF + m * 16) * ldc + col0;
#pragma unroll
                for (int bj = 0; bj < 2; ++bj) { f32x4 v0 = acc[ai][bj][m][0] + bv[bj][0], v1 = acc[ai][bj][m][1] + bv[bj][1];
                    if (ACT == 1) { f32x2 a = gelu_pk((f32x2){v0[0], v0[1]}), b = gelu_pk((f32x2){v0[2], v0[3]}), c = gelu_pk((f32x2){v1[0], v1[1]}), d = gelu_pk((f32x2){v1[2], v1[3]});
                        v0 = (f32x4){a.x, a.y, b.x, b.y}; v1 = (f32x4){c.x, c.y, d.x, d.y}; }
                    if (ACT == 2) {
#pragma unroll
                        for (int j = 0; j < 4; ++j) { v0[j] = 0.5f * v0[j] * (1.0f + erff(v0[j] * 0.70710678f)); v1[j] = 0.5f * v1[j] * (1.0f + erff(v1[j] * 0.70710678f)); } }
                    u32x4 w; w.x = cvt_pk_bf16(v0[0], v0[1]); w.y = cvt_pk_bf16(v0[2], v0[3]); w.z = cvt_pk_bf16(v1[0], v1[1]); w.w = cvt_pk_bf16(v1[2], v1[3]);
                    *(u32x4*)(rowp + bj * HALF) = w; } }
    }
};

template <class Epi, class Sched, bool STAMP = false>
__device__ __forceinline__ void gemm_phase(PG8_LAS unsigned char* lds, const Gemm g, const Sched& S, const Epi& E, unsigned long long* stamps) {
    const int tid = threadIdx.x, wid = __builtin_amdgcn_readfirstlane(tid >> 6), lane = tid & 63, wr = wid >> 2, wc = wid & 3, fr = lane & 15, fq = lane >> 4;
    const int K = g.K, nt = K / BK;
    int ts_lo = 0, ts_hi = 0, nts = 0; const unsigned long long rt_entry = STAMP ? (unsigned long long)wall_clock64() : 0ull;
#define PG8_STAMP() do { if (STAMP && wid == 0 && nts < 64) { const unsigned long long _c = (unsigned long long)clock64(); \
        ts_lo = (lane == nts) ? (int)(unsigned)_c : ts_lo; ts_hi = (lane == nts) ? (int)(unsigned)(_c >> 32) : ts_hi; ++nts; } } while (0)
    PG8_STAMP();
    unsigned voffA[2], voffB[2];
#pragma unroll
    for (int i = 0; i < 2; ++i) { int R, C; stage_rc(tid * 16 + i * 8192, R, C); const int Rb = Epi::PERM ? ((R & ~31) + perm32(R & 31)) : R;
        voffA[i] = (unsigned)(R * K + C) * 2u; voffB[i] = (unsigned)(Rb * K + C) * 2u; }
    const size_t kstep = (size_t)(BK * 2);
    const size_t hstep = (size_t)HALF * K * 2;
    const size_t tstep = 2 * hstep;
    const unsigned ldsw = (unsigned)wid * 1024u;
    const int aoff = lds_byte(wr * 64 + fr, fq * 8), boff = lds_byte(wc * 32 + fr, fq * 8);
#define PG8_SA(b, h) (((b) * 2 + (h)) * HTB)
#define PG8_SB(b, h) ((4 + (b) * 2 + (h)) * HTB)
#define PG8_STAGE(bufoff, gbase, voff) do { _Pragma("unroll") for (int _i = 0; _i < 2; ++_i) \
        __builtin_amdgcn_global_load_lds((const unsigned*)((const char*)(gbase) + (voff)[_i]), (PG8_LAS unsigned*)(lds + (bufoff) + ldsw + _i * 8192), 16, 0, 0); } while (0)
#define PG8_LDA(dst, b, h) do { _Pragma("unroll") for (int m = 0; m < 4; ++m) _Pragma("unroll") for (int k = 0; k < 2; ++k) dst[m][k] = *(const PG8_LAS bf16x8*)(lds + PG8_SA(b, h) + aoff + m * 2048 + k * 1024); } while (0)
#define PG8_LDB(dst, b, h) do { _Pragma("unroll") for (int n = 0; n < 2; ++n) _Pragma("unroll") for (int k = 0; k < 2; ++k) dst[n][k] = *(const PG8_LAS bf16x8*)(lds + PG8_SB(b, h) + boff + n * 2048 + k * 1024); } while (0)
#define PG8_MMA(ai, bj, At, Bt) do { __builtin_amdgcn_s_setprio(1); _Pragma("unroll") for (int m = 0; m < 4; ++m) _Pragma("unroll") for (int n = 0; n < 2; ++n) _Pragma("unroll") for (int k = 0; k < 2; ++k) \
        acc[ai][bj][m][n] = __builtin_amdgcn_mfma_f32_16x16x32_bf16(Bt[n][k], At[m][k], acc[ai][bj][m][n], 0, 0, 0); __builtin_amdgcn_s_setprio(0); } while (0)
#define PG8_WAIT_V(n) asm volatile("s_waitcnt vmcnt(" #n ")" ::: "memory")
#define PG8_WAIT_L(n) asm volatile("s_waitcnt lgkmcnt(" #n ")" ::: "memory")
#define PG8_BAR __builtin_amdgcn_s_barrier()
#define PG8_SCHED __builtin_amdgcn_sched_barrier(0)
    Unit cur, nxt; int ui = 0;
    if (!S.next(0, cur)) return;
    f32x4 acc[2][2][4][2];
#pragma unroll
    for (int a = 0; a < 2; ++a)
#pragma unroll
        for (int b = 0; b < 2; ++b)
#pragma unroll
            for (int m = 0; m < 4; ++m)
#pragma unroll
                for (int n = 0; n < 2; ++n) acc[a][b][m][n] = (f32x4){0.f, 0.f, 0.f, 0.f};
    bf16x8 At[4][2], B0[2][2], B1[2][2];
    const char* cA = (const char*)g.A + (size_t)cur.pm * tstep; const char* cB = (const char*)g.Bt + (size_t)cur.pn * tstep;
    S.a_ready(cur);
    PG8_STAGE(PG8_SB(0, 0), cB, voffB); PG8_STAGE(PG8_SA(0, 0), cA, voffA); PG8_STAGE(PG8_SB(0, 1), cB + hstep, voffB); PG8_STAGE(PG8_SA(0, 1), cA + hstep, voffA);
    if (wr == 1) PG8_BAR;
    PG8_WAIT_V(4); PG8_BAR;
    PG8_STAGE(PG8_SB(1, 0), cB + kstep, voffB); PG8_STAGE(PG8_SA(1, 0), cA + kstep, voffA); PG8_STAGE(PG8_SB(1, 1), cB + hstep + kstep, voffB);
    PG8_WAIT_V(6); PG8_BAR;
    PG8_STAMP();
    for (;;) {
        const bool has_next = S.next(ui + 1, nxt);
        const char* nA = has_next ? (const char*)g.A + (size_t)nxt.pm * tstep : cA; const char* nB = has_next ? (const char*)g.Bt + (size_t)nxt.pn * tstep : cB;
        for (int t = 0; t < nt; t += 2) {
            const bool last = (t == nt - 2);
            const char* a1 = cA + (size_t)(t + 1) * kstep;
            const char* a2 = last ? nA : cA + (size_t)(t + 2) * kstep; const char* b2 = last ? nB : cB + (size_t)(t + 2) * kstep;
            const char* a3 = a2 + kstep; const char* b3 = b2 + kstep;
            if (last && has_next) S.a_ready(nxt);
            PG8_LDB(B0, 0, 0); PG8_SCHED; PG8_LDA(At, 0, 0); PG8_STAGE(PG8_SA(1, 1), a1 + hstep, voffA);
            PG8_WAIT_L(8); PG8_BAR; PG8_WAIT_L(0); PG8_MMA(0, 0, At, B0); PG8_BAR; PG8_SCHED;
            PG8_LDB(B1, 0, 1); PG8_STAGE(PG8_SB(0, 0), b2, voffB);
            PG8_BAR; PG8_WAIT_L(0); PG8_MMA(0, 1, At, B1); PG8_BAR;
            PG8_LDA(At, 0, 1); PG8_STAGE(PG8_SA(0, 0), a2, voffA);
            PG8_BAR; PG8_WAIT_L(0); PG8_MMA(1, 0, At, B0); PG8_BAR; PG8_SCHED;
            PG8_STAGE(PG8_SB(0, 1), b2 + hstep, voffB);
            PG8_WAIT_V(6); PG8_BAR; PG8_MMA(1, 1, At, B1); PG8_BAR;
            PG8_LDB(B0, 1, 0); PG8_SCHED; PG8_LDA(At, 1, 0); PG8_STAGE(PG8_SA(0, 1), a2 + hstep, voffA);
            PG8_WAIT_L(8); PG8_BAR; PG8_WAIT_L(0); PG8_MMA(0, 0, At, B0); PG8_BAR; PG8_SCHED;
            PG8_LDB(B1, 1, 1); PG8_STAGE(PG8_SB(1, 0), b3, voffB);
            PG8_BAR; PG8_WAIT_L(0); PG8_MMA(0, 1, At, B1); PG8_BAR;
            PG8_LDA(At, 1, 1); PG8_STAGE(PG8_SA(1, 0), a3, voffA);
            PG8_BAR; PG8_WAIT_L(0); PG8_MMA(1, 0, At, B0); PG8_BAR; PG8_SCHED;
            PG8_STAGE(PG8_SB(1, 1), b3 + hstep, voffB);
            PG8_WAIT_V(6); PG8_BAR; PG8_MMA(1, 1, At, B1); PG8_BAR;
        }
        PG8_STAMP();
        if constexpr (!Epi::AFTER_DRAIN) { E(acc, cur, wr, wc, fr, fq); S.done(cur); }
        PG8_STAMP();
        if (!has_next) break;
#pragma unroll
        for (int a = 0; a < 2; ++a)
#pragma unroll
            for (int b = 0; b < 2; ++b)
#pragma unroll
                for (int m = 0; m < 4; ++m)
#pragma unroll
                    for (int n = 0; n < 2; ++n) acc[a][b][m][n] = (f32x4){0.f, 0.f, 0.f, 0.f};
        cur = nxt; cA = nA; cB = nB; ++ui;
    }
    PG8_WAIT_V(0);
    if (wr == 0) PG8_BAR;
    PG8_BAR;
    if constexpr (Epi::AFTER_DRAIN) { E.fused(acc, cur, wr, wc, fr, fq, lds, wid, lane); S.done(cur); }
    PG8_STAMP();
    if (STAMP && wid == 0) { stamps[lane] = lane < nts ? (((unsigned long long)(unsigned)ts_hi << 32) | (unsigned)ts_lo) : 0ull;
        if (lane == 62) stamps[62] = rt_entry; if (lane == 63) stamps[63] = (unsigned long long)wall_clock64(); }
#undef PG8_STAMP
#undef PG8_SA
#undef PG8_SB
#undef PG8_STAGE
#undef PG8_LDA
#undef PG8_LDB
#undef PG8_MMA
#undef PG8_WAIT_V
#undef PG8_WAIT_L
#undef PG8_BAR
#undef PG8_SCHED
}
}

constexpr int D = 1024, NB = 8, T = 4096, MTOK = NB * T;
constexpr int NP = 3840;
constexpr int CA_U = 0, CA_V = 512, CA_G = 1024;
constexpr int CB0 = 1536;
constexpr int CB_R = 0, CB_K = 512, CB_V = 1024, CB_G = 1536, CB_WD = 2048;
constexpr float ALPHA = 1.189207115f;
constexpr float LN_EPS = 1e-5f, GN_EPS = 64e-5f;
constexpr int LDS_BYTES = 131072;

typedef unsigned short bf16_t;
typedef short bf16x8 __attribute__((ext_vector_type(8)));
typedef float f32x4 __attribute__((ext_vector_type(4)));
typedef float f32x2 __attribute__((ext_vector_type(2)));
typedef float f32x16 __attribute__((ext_vector_type(16)));
typedef unsigned u32x4 __attribute__((ext_vector_type(4)));
typedef unsigned u32x2 __attribute__((ext_vector_type(2)));
#define DI __device__ __forceinline__
#define MFMA32(a, b, c) __builtin_amdgcn_mfma_f32_32x32x16_bf16((a), (b), (c), 0, 0, 0)

DI float bf2f(bf16_t v) { return __uint_as_float(((unsigned)v) << 16); }
DI float bflo(unsigned w) { return __uint_as_float(w << 16); }
DI float bfhi(unsigned w) { return __uint_as_float(w & 0xffff0000u); }
DI bf16_t f2bf(float f) { unsigned u = __float_as_uint(f); u += 0x7fffu + ((u >> 16) & 1u); return (bf16_t)(u >> 16); }
DI unsigned pk2(float lo, float hi) { return (unsigned)f2bf(lo) | ((unsigned)f2bf(hi) << 16); }
DI float sigm(float x) { return 1.f / (1.f + __expf(-x)); }
DI float silu(float x) { return x / (1.f + __expf(-x)); }
DI float gelu_tanh(float x) { const float u = 1.5957691216f * (x + 0.044715f * x * x * x); return x / (1.f + __expf(-u)); }
DI int crow(int reg, int h) { return (reg & 3) + 8 * (reg >> 2) + 4 * h; }
template <int CTRL> DI float dppf(float x) { return __int_as_float(__builtin_amdgcn_update_dpp(0, __float_as_int(x), CTRL, 0xF, 0xF, true)); }
DI float reduce16(float x) { x += dppf<0xB1>(x); x += dppf<0x4E>(x); x += dppf<0x141>(x); x += dppf<0x140>(x); return x; }
DI float reduce32(float x) { x = reduce16(x); x += __shfl_xor(x, 16); return x; }

struct Params {
    const float *x, *c, *w_ada, *b_ada, *w_in, *mu_b, *ln_v_g, *ln_v_b, *w_spatial, *b_spatial, *w0, *w_up, *a0, *a_up, *k_k, *k_a, *r_k, *gn_g, *gn_b, *w_out, *ln_g, *ln_b;
    float* out;
    float* mod;
    bf16_t* hbf;
    bf16_t* wt_in;
    bf16_t* wt_out;
    bf16_t* wupT;
    bf16_t* aupT;
    bf16_t* p;
    bf16_t *sr, *sk, *sv, *skk, *sb;
    float* slw;
    float* y;
    int phase_lo, phase_hi;
};

DI void tr_tile(const float* src, int ld, int ncols, bf16_t* dst, int ldd, int kt, int nt, float* red) {
    const int tid = threadIdx.x, kr = tid >> 3, c8 = (tid & 7) * 8, n0 = nt * 64;
    f32x4 a = {0.f, 0.f, 0.f, 0.f}, b = a;
    if (n0 + c8 < ncols) { const float* s = src + (size_t)(kt * 64 + kr) * ld + n0 + c8; a = *(const f32x4*)s; b = *(const f32x4*)(s + 4); }
    float* tr = red + kr * 65 + c8;
    tr[0] = a[0]; tr[1] = a[1]; tr[2] = a[2]; tr[3] = a[3]; tr[4] = b[0]; tr[5] = b[1]; tr[6] = b[2]; tr[7] = b[3];
    __syncthreads();
    const int n = tid >> 3, kgp = (tid & 7) * 8;
    u32x4 w;
    w.x = pk2(red[(kgp + 0) * 65 + n], red[(kgp + 1) * 65 + n]); w.y = pk2(red[(kgp + 2) * 65 + n], red[(kgp + 3) * 65 + n]);
    w.z = pk2(red[(kgp + 4) * 65 + n], red[(kgp + 5) * 65 + n]); w.w = pk2(red[(kgp + 6) * 65 + n], red[(kgp + 7) * 65 + n]);
    *(u32x4*)(dst + (size_t)(n0 + n) * ldd + kt * 64 + kgp) = w;
    __syncthreads();
}
__device__ void phase0(const Params& P, unsigned char* lds) {
    float* sc = (float*)lds;
    float* red = sc + 8192;
    const int tid = threadIdx.x;
    for (int i = tid; i < 8192; i += 512) sc[i] = silu(P.c[i]);
    __syncthreads();
    constexpr int NMOD = 192, NTIN = 960, NTOUT = 256, NTUP = 16;
    for (int it = blockIdx.x; it < NMOD + NTIN + NTOUT + NTUP; it += gridDim.x) {
        if (it < NMOD) {
            const int cl = tid & 15, n = it * 16 + cl, kg = tid >> 4;
            float acc[8];
#pragma unroll
            for (int b = 0; b < 8; ++b) acc[b] = 0.f;
            for (int i = 0; i < 32; ++i) {
                const int k = kg + 32 * i; const float w = P.w_ada[(size_t)k * 3072 + n];
#pragma unroll
                for (int b = 0; b < 8; ++b) acc[b] += sc[b * 1024 + k] * w;
            }
#pragma unroll
            for (int b = 0; b < 8; ++b) red[(kg * 16 + cl) * 8 + b] = acc[b];
            __syncthreads();
            if (tid < 128) { const int b = tid >> 4, c2 = tid & 15; float s = 0.f; for (int g = 0; g < 32; ++g) s += red[(g * 16 + c2) * 8 + b];
                P.mod[b * 3072 + it * 16 + c2] = s + P.b_ada[it * 16 + c2]; }
            __syncthreads();
        } else {
            int j = it - NMOD;
            if (j < NTIN) tr_tile(P.w_in, 3712, 3712, P.wt_in, 1024, j & 15, j >> 4, red);
            else if (j < NTIN + NTOUT) { j -= NTIN; tr_tile(P.w_out, 1024, 1024, P.wt_out, 1024, j & 15, j >> 4, red); }
            else if (j < NTIN + NTOUT + 8) { j -= NTIN + NTOUT; tr_tile(P.w_up, 512, 512, P.wupT, 64, 0, j & 7, red); }
            else { j -= NTIN + NTOUT + 8; tr_tile(P.a_up, 512, 512, P.aupT, 64, 0, j & 7, red); }
        }
    }
}

__device__ void phase1(const Params& P) {
    for (size_t idx = (size_t)blockIdx.x * 512 + threadIdx.x; idx < (size_t)MTOK * 128; idx += (size_t)gridDim.x * 512) {
        const int m = (int)(idx >> 7), c8 = (int)(idx & 127) * 8, b = m >> 12;
        const float* xp = P.x + (size_t)m * D + c8; const float* sh = P.mod + b * 3072 + c8; const float* scp = sh + 1024;
        const f32x4 x0 = *(const f32x4*)xp, x1 = *(const f32x4*)(xp + 4), s0 = *(const f32x4*)sh, s1 = *(const f32x4*)(sh + 4), c0 = *(const f32x4*)scp, c1 = *(const f32x4*)(scp + 4);
        const f32x4 h0 = x0 * (1.f + c0) + s0, h1 = x1 * (1.f + c1) + s1;
        u32x4 w; w.x = pk2(h0[0], h0[1]); w.y = pk2(h0[2], h0[3]); w.z = pk2(h1[0], h1[1]); w.w = pk2(h1[2], h1[3]);
        *(u32x4*)(P.hbf + (size_t)m * D + c8) = w;
    }
}

__device__ void phase3a(const Params& P, unsigned char* lds) {
    bf16_t* Wm = (bf16_t*)lds;
    bf16_t* Vt = Wm + 128 * 136;
    const int tid = threadIdx.x, wv = tid >> 6, lane = tid & 63, r = lane & 31, h = lane >> 5;
    int cur_g = -1;
    for (int it = blockIdx.x; it < 2048; it += gridDim.x) {
        const int g = it & 7, bc = it >> 3; const size_t row0 = (size_t)bc * 128;
        if (g != cur_g) {
            cur_g = g;
            for (int e = tid; e < 2048; e += 512) {
                const int t = e >> 4, s8 = (e & 15) * 8; const float* s = P.w_spatial + ((size_t)g * 128 + t) * 128 + s8;
                const f32x4 a = *(const f32x4*)s, b = *(const f32x4*)(s + 4);
                float v[8] = {a[0], a[1], a[2], a[3], b[0], b[1], b[2], b[3]};
#pragma unroll
                for (int j = 0; j < 8; ++j) v[j] = (s8 + j <= t) ? v[j] : 0.f;
                u32x4 w; w.x = pk2(v[0], v[1]); w.y = pk2(v[2], v[3]); w.z = pk2(v[4], v[5]); w.w = pk2(v[6], v[7]);
                *(u32x4*)(Wm + t * 136 + s8) = w;
            }
        }
        {
            const int t = tid >> 2, dq = (tid & 3) * 16;
            const bf16_t* src = P.p + (row0 + t) * NP + CA_V + 64 * g + dq;
            const u32x4 q0 = *(const u32x4*)src, q1 = *(const u32x4*)(src + 8);
            float v[16] = {bflo(q0.x), bfhi(q0.x), bflo(q0.y), bfhi(q0.y), bflo(q0.z), bfhi(q0.z), bflo(q0.w), bfhi(q0.w),
                           bflo(q1.x), bfhi(q1.x), bflo(q1.y), bfhi(q1.y), bflo(q1.z), bfhi(q1.z), bflo(q1.w), bfhi(q1.w)};
            float s = 0.f;
#pragma unroll
            for (int j = 0; j < 16; ++j) { v[j] = gelu_tanh(v[j]); s += v[j]; }
            s += __shfl_xor(s, 1); s += __shfl_xor(s, 2);
            const float mean = s * (1.f / 64.f);
            float q = 0.f;
#pragma unroll
            for (int j = 0; j < 16; ++j) { v[j] -= mean; q += v[j] * v[j]; }
            q += __shfl_xor(q, 1); q += __shfl_xor(q, 2);
            const float rstd = rsqrtf(q * (1.f / 64.f) + LN_EPS);
#pragma unroll
            for (int j = 0; j < 16; ++j) { const int d = dq + j; Vt[d * 136 + t] = f2bf(v[j] * rstd * P.ln_v_g[g * 64 + d] + P.ln_v_b[g * 64 + d]); }
        }
        __syncthreads();
        const int t0 = 32 * (wv >> 1), d0 = 32 * (wv & 1);
        f32x16 acc;
#pragma unroll
        for (int i = 0; i < 16; ++i) acc[i] = 0.f;
        for (int ks = 0; ks < 8; ++ks) {
            if (16 * ks > t0 + 31) break;
            const bf16x8 a = *(const bf16x8*)(Wm + (t0 + r) * 136 + 16 * ks + 8 * h);
            const bf16x8 b = *(const bf16x8*)(Vt + (d0 + r) * 136 + 16 * ks + 8 * h);
            acc = MFMA32(a, b, acc);
        }
#pragma unroll
        for (int i = 0; i < 16; ++i) {
            const int t = t0 + crow(i, h), d = d0 + r; const bf16_t* pr = P.p + (row0 + t) * NP + 64 * g + d;
            const float u = bf2f(pr[CA_U]), gt = bf2f(pr[CA_G]);
            const float val = (acc[i] + P.b_spatial[g * 128 + t]) * gelu_tanh(u) * silu(gt);
            P.hbf[(row0 + t) * D + 64 * g + d] = f2bf(val);
        }
        __syncthreads();
    }
}

DI float xs_at(const Params& P, size_t row, int cb) {
    const bf16_t* q = P.p + row * NP + CB0 + cb; const float cur = bf2f(q[0]);
    const float prev = (row & 4095) ? bf2f(*(q - NP)) : 0.f;
    return cur + P.mu_b[cb] * (prev - cur);
}
__device__ void phase3b(const Params& P, unsigned char* lds) {
    bf16_t* Awd = (bf16_t*)lds;
    bf16_t* Aad = Awd + 64 * 72;
    float* ssn = (float*)(Aad + 64 * 72);
    const int tid = threadIdx.x, wv = tid >> 6, lane = tid & 63, r = lane & 31, h = lane >> 5;
    for (int it = blockIdx.x; it < 512; it += gridDim.x) {
        const size_t m0 = (size_t)it * 64;
        {
            const int t = tid >> 3, c16 = (tid & 7) * 16; const size_t row = m0 + t;
            const bf16_t* q = P.p + row * NP + CB0 + CB_WD + c16; const bool hasprev = (row & 4095) != 0;
            const u32x4 z = {0u, 0u, 0u, 0u};
            const u32x4 c0 = *(const u32x4*)q, c1 = *(const u32x4*)(q + 8);
            const u32x4 p0 = hasprev ? *(const u32x4*)(q - NP) : z, p1 = hasprev ? *(const u32x4*)(q - NP + 8) : z;
            const unsigned cw[8] = {c0.x, c0.y, c0.z, c0.w, c1.x, c1.y, c1.z, c1.w}, pw[8] = {p0.x, p0.y, p0.z, p0.w, p1.x, p1.y, p1.z, p1.w};
            unsigned ow[8];
#pragma unroll
            for (int j = 0; j < 8; ++j) {
                const float m_lo = P.mu_b[CB_WD + c16 + 2 * j], m_hi = P.mu_b[CB_WD + c16 + 2 * j + 1];
                float lo = bflo(cw[j]), hi = bfhi(cw[j]);
                lo += m_lo * (bflo(pw[j]) - lo); hi += m_hi * (bfhi(pw[j]) - hi);
                if (c16 < 64) { lo = tanhf(lo); hi = tanhf(hi); }
                ow[j] = pk2(lo, hi);
            }
            bf16_t* dst = (c16 < 64) ? (Awd + t * 72 + c16) : (Aad + t * 72 + (c16 - 64));
            *(u32x4*)dst = (u32x4){ow[0], ow[1], ow[2], ow[3]}; *(u32x4*)(dst + 8) = (u32x4){ow[4], ow[5], ow[6], ow[7]};
        }
        for (int rd = 0; rd < 16; ++rd) {
            const int pair = rd * 32 + (tid >> 4), t = pair >> 3, hd = pair & 7, l16 = tid & 15; const size_t row = m0 + t;
            float s = 0.f;
#pragma unroll
            for (int j = 0; j < 4; ++j) { const int n = hd * 64 + l16 * 4 + j; const float kk = xs_at(P, row, CB_K + n) * P.k_k[n]; s += kk * kk; }
            s = reduce16(s);
            if (l16 == 0) ssn[t * 8 + hd] = rsqrtf(s + 1e-12f);
        }
        __syncthreads();
        const int hd = wv;
        for (int tt = 0; tt < 2; ++tt) {
            f32x16 aw[2], aa[2];
#pragma unroll
            for (int i = 0; i < 16; ++i) { aw[0][i] = 0.f; aw[1][i] = 0.f; aa[0][i] = 0.f; aa[1][i] = 0.f; }
#pragma unroll
            for (int ks = 0; ks < 4; ++ks) {
                const bf16x8 fw = *(const bf16x8*)(Awd + (tt * 32 + r) * 72 + 16 * ks + 8 * h);
                const bf16x8 fa = *(const bf16x8*)(Aad + (tt * 32 + r) * 72 + 16 * ks + 8 * h);
#pragma unroll
                for (int nt = 0; nt < 2; ++nt) {
                    const bf16x8 bw = *(const bf16x8*)(P.wupT + (size_t)(hd * 64 + nt * 32 + r) * 64 + 16 * ks + 8 * h);
                    const bf16x8 ba = *(const bf16x8*)(P.aupT + (size_t)(hd * 64 + nt * 32 + r) * 64 + 16 * ks + 8 * h);
                    aw[nt] = MFMA32(fw, bw, aw[nt]); aa[nt] = MFMA32(fa, ba, aa[nt]);
                }
            }
#pragma unroll
            for (int nt = 0; nt < 2; ++nt) {
                const int n = hd * 64 + nt * 32 + r;
                const float w0n = P.w0[n], a0n = P.a0[n], kkn_ = P.k_k[n], kan = P.k_a[n];
#pragma unroll
                for (int i = 0; i < 16; ++i) {
                    const int t = tt * 32 + crow(i, h); const size_t row = m0 + t;
                    const float xr = xs_at(P, row, CB_R + n), xk = xs_at(P, row, CB_K + n), xv = xs_at(P, row, CB_V + n);
                    const float wp = w0n + aw[nt][i], z = -wp;
                    const float sp = fmaxf(z, 0.f) + log1pf(__expf(-fabsf(z)));
                    const float lw = -__expf(-sp - 0.5f);
                    const float a = sigm(a0n + aa[nt][i]);
                    const float kk = xk * kkn_ * ssn[t * 8 + hd];
                    const float kp = xk * (1.f + (a - 1.f) * kan);
                    const size_t o = row * 512 + n;
                    P.sr[o] = f2bf(xr); P.sk[o] = f2bf(kp); P.sv[o] = f2bf(xv); P.skk[o] = f2bf(kk); P.sb[o] = f2bf(kk * a); P.slw[o] = lw;
                }
            }
        }
        __syncthreads();
    }
}

__device__ void phase4(const Params& P, unsigned char* lds) {
    constexpr int TB = 32, BUF = 5 * TB * 64 + 2 * TB * 16;
    float* base = (float*)lds;
    const int tid = threadIdx.x, wv = tid >> 6, lane = tid & 63, jl = lane & 31, ir = wv * 2 + (lane >> 5);
    for (int it = blockIdx.x; it < 256; it += gridDim.x) {
        const int bh = it >> 2, rg = it & 3, b = bh >> 3, hd = bh & 7;
        const size_t rowb = (size_t)b * T; const int ch0 = hd * 64;
        const int tok = tid >> 4, c4 = (tid & 15) * 4;
        const int vtok = tid >> 2, vc4 = (tid & 3) * 4;
        u32x2 gr, gk, ga, gb, gv; f32x4 gw;
        auto gload = [&](int nb) {
            const size_t o = (rowb + (size_t)nb * TB + tok) * 512 + ch0 + c4;
            gr = *(const u32x2*)(P.sr + o); gk = *(const u32x2*)(P.sk + o); ga = *(const u32x2*)(P.skk + o); gb = *(const u32x2*)(P.sb + o); gw = *(const f32x4*)(P.slw + o);
            if (tid < 128) gv = *(const u32x2*)(P.sv + (rowb + (size_t)nb * TB + vtok) * 512 + ch0 + rg * 16 + vc4);
        };
        auto lstore = [&](float* bf) {
            float* q = bf + tok * 64 + c4;
            *(f32x4*)(q) = (f32x4){bflo(gr.x), bfhi(gr.x), bflo(gr.y), bfhi(gr.y)};
            *(f32x4*)(q + TB * 64) = (f32x4){__expf(gw[0]), __expf(gw[1]), __expf(gw[2]), __expf(gw[3])};
            *(f32x4*)(q + 2 * TB * 64) = (f32x4){bflo(gk.x), bfhi(gk.x), bflo(gk.y), bfhi(gk.y)};
            *(f32x4*)(q + 3 * TB * 64) = (f32x4){bflo(ga.x), bfhi(ga.x), bflo(ga.y), bfhi(ga.y)};
            *(f32x4*)(q + 4 * TB * 64) = (f32x4){bflo(gb.x), bfhi(gb.x), bflo(gb.y), bfhi(gb.y)};
            if (tid < 128) *(f32x4*)(bf + 5 * TB * 64 + vtok * 16 + vc4) = (f32x4){bflo(gv.x), bfhi(gv.x), bflo(gv.y), bfhi(gv.y)};
        };
        gload(0); lstore(base); __syncthreads();
        float s0 = 0.f, s1 = 0.f;
        for (int nb = 0; nb < T / TB; ++nb) {
            float* cur = base + (nb & 1) * BUF; float* nxt = base + ((nb + 1) & 1) * BUF;
            if (nb + 1 < T / TB) gload(nb + 1);
            const float* R = cur; const float* W = cur + TB * 64; const float* K = cur + 2 * TB * 64; const float* A = cur + 3 * TB * 64; const float* Bq = cur + 4 * TB * 64;
            const float* V = cur + 5 * TB * 64; float* Y = cur + 5 * TB * 64 + TB * 16;
#pragma unroll 4
            for (int st = 0; st < TB; ++st) {
                const f32x2 a2 = *(const f32x2*)(A + st * 64 + 2 * jl), w2 = *(const f32x2*)(W + st * 64 + 2 * jl), k2 = *(const f32x2*)(K + st * 64 + 2 * jl);
                const f32x2 b2 = *(const f32x2*)(Bq + st * 64 + 2 * jl), r2 = *(const f32x2*)(R + st * 64 + 2 * jl);
                const float vi = V[st * 16 + ir];
                float sa = -(s0 * a2.x + s1 * a2.y);
                sa = reduce32(sa);
                s0 = s0 * w2.x + sa * b2.x + vi * k2.x;
                s1 = s1 * w2.y + sa * b2.y + vi * k2.y;
                float yy = s0 * r2.x + s1 * r2.y;
                yy = reduce32(yy);
                if (jl == 0) Y[st * 16 + ir] = yy;
            }
            if (nb + 1 < T / TB) lstore(nxt);
            __syncthreads();
            if (tid < 128) *(f32x4*)(P.y + (rowb + (size_t)nb * TB + vtok) * 512 + ch0 + rg * 16 + vc4) = *(const f32x4*)(Y + vtok * 16 + vc4);
        }
        __syncthreads();
    }
}

__device__ void phase5(const Params& P) {
    const int tid = threadIdx.x, tl = tid >> 7, hd = (tid >> 4) & 7, l16 = tid & 15, n = hd * 64 + l16 * 4;
    for (int it = blockIdx.x; it < MTOK / 4; it += gridDim.x) {
        const size_t row = (size_t)it * 4 + tl, o = row * 512 + n;
        const f32x4 yv = *(const f32x4*)(P.y + o);
        float s = yv[0] + yv[1] + yv[2] + yv[3]; s = reduce16(s);
        const float mean = s * (1.f / 64.f);
        const f32x4 dv = yv - mean;
        float q = dv[0] * dv[0] + dv[1] * dv[1] + dv[2] * dv[2] + dv[3] * dv[3]; q = reduce16(q);
        const float rstd = rsqrtf(q * (1.f / 64.f) + GN_EPS);
        const u32x2 rr = *(const u32x2*)(P.sr + o), kk = *(const u32x2*)(P.sk + o), vv = *(const u32x2*)(P.sv + o);
        const float rv[4] = {bflo(rr.x), bfhi(rr.x), bflo(rr.y), bfhi(rr.y)}, kv[4] = {bflo(kk.x), bfhi(kk.x), bflo(kk.y), bfhi(kk.y)}, v4[4] = {bflo(vv.x), bfhi(vv.x), bflo(vv.y), bfhi(vv.y)};
        float bs = 0.f;
#pragma unroll
        for (int j = 0; j < 4; ++j) bs += rv[j] * kv[j] * P.r_k[n + j];
        bs = reduce16(bs);
        float ov[4];
#pragma unroll
        for (int j = 0; j < 4; ++j) {
            const float yn = dv[j] * rstd * P.gn_g[n + j] + P.gn_b[n + j];
            const float g = xs_at(P, row, CB_G + n + j);
            ov[j] = (yn + bs * v4[j]) * silu(g);
        }
        *(u32x2*)(P.hbf + row * D + 512 + n) = (u32x2){pk2(ov[0], ov[1]), pk2(ov[2], ov[3])};
    }
}

struct EpiOut {
    static constexpr bool PERM = false, AFTER_DRAIN = false;
    float* C; const float* x; const float* mod;
    __device__ __forceinline__ void operator()(const pg8::f32x4 (&acc)[2][2][4][2], const pg8::Unit& u, int wr, int wc, int fr, int fq) const {
        const int row0 = u.pm * 256 + wr * 64 + fr, col0 = u.pn * 256 + wc * 32 + 4 * fq, b = (u.pm * 256) >> 12;
        pg8::f32x4 gv[2][2];
#pragma unroll
        for (int bj = 0; bj < 2; ++bj)
#pragma unroll
            for (int n = 0; n < 2; ++n) gv[bj][n] = *(const pg8::f32x4*)(mod + b * 3072 + 2048 + col0 + bj * 128 + n * 16);
#pragma unroll
        for (int ai = 0; ai < 2; ++ai)
#pragma unroll
            for (int m = 0; m < 4; ++m) { const size_t ro = (size_t)(row0 + ai * 128 + m * 16) * 1024 + col0;
#pragma unroll
                for (int bj = 0; bj < 2; ++bj)
#pragma unroll
                    for (int n = 0; n < 2; ++n) { const pg8::f32x4 xv = *(const pg8::f32x4*)(x + ro + bj * 128 + n * 16);
                        *(pg8::f32x4*)(C + ro + bj * 128 + n * 16) = xv * ALPHA + gv[bj][n] * acc[ai][bj][m][n]; } }
    }
};

__device__ void phase7(const Params& P) {
    const int wv = threadIdx.x >> 6, lane = threadIdx.x & 63;
    for (int it = blockIdx.x; it < MTOK / 8; it += gridDim.x) {
        float* rp = P.out + ((size_t)it * 8 + wv) * D + lane * 4;
        f32x4 v[4];
#pragma unroll
        for (int q = 0; q < 4; ++q) v[q] = *(const f32x4*)(rp + 256 * q);
        float s = 0.f;
#pragma unroll
        for (int q = 0; q < 4; ++q) s += v[q][0] + v[q][1] + v[q][2] + v[q][3];
#pragma unroll
        for (int o = 32; o > 0; o >>= 1) s += __shfl_xor(s, o);
        const float mean = s * (1.f / 1024.f);
        float qq = 0.f;
#pragma unroll
        for (int q = 0; q < 4; ++q) { v[q] = v[q] - mean; qq += v[q][0] * v[q][0] + v[q][1] * v[q][1] + v[q][2] * v[q][2] + v[q][3] * v[q][3]; }
#pragma unroll
        for (int o = 32; o > 0; o >>= 1) qq += __shfl_xor(qq, o);
        const float rstd = rsqrtf(qq * (1.f / 1024.f) + LN_EPS);
#pragma unroll
        for (int q = 0; q < 4; ++q) { const f32x4 g = *(const f32x4*)(P.ln_g + lane * 4 + 256 * q), bb = *(const f32x4*)(P.ln_b + lane * 4 + 256 * q);
            *(f32x4*)(rp + 256 * q) = v[q] * rstd * g + bb; }
    }
}

constexpr int NPHASE = 8;
#ifndef PHM
#define PHM 511
#endif
__global__ void __launch_bounds__(512, 2) mega(Params Pin) {
    extern __shared__ __attribute__((aligned(16))) unsigned char lds[];
    cg::grid_group grid = cg::this_grid();
    typedef const __attribute__((address_space(4))) Params* KP;
    const KP kp = (KP)__builtin_amdgcn_kernarg_segment_ptr();
    const int ph_lo = kp->phase_lo, ph_hi = kp->phase_hi;
#if defined(__HIP_DEVICE_COMPILE__)
#define LOADP() KP q = kp; asm volatile("" : "+s"(q)); const Params P = *q
#else
#define LOADP() const Params P = Pin
#endif
#define RUNS(ph) (ph_lo <= (ph) && (ph) < ph_hi)
#define SYNC_AFTER(ph) if (ph_lo <= (ph) && (ph) + 1 < ph_hi) grid.sync()
    if (RUNS(0)) { LOADP(); if (PHM & 1) phase0(P, lds); }
    SYNC_AFTER(0);
    if (RUNS(1)) { LOADP(); if (PHM & 2) phase1(P); }
    SYNC_AFTER(1);
    if (RUNS(2)) { LOADP(); if (PHM & 4) {
        pg8::Gemm g{P.hbf, P.wt_in, MTOK, NP, D}; pg8::StaticOrder S; S.init(MTOK, NP, (int)gridDim.x, (int)blockIdx.x);
        pg8::EpiBf16<0> E{P.p, NP, nullptr, 0, 0};
        pg8::gemm_phase<pg8::EpiBf16<0>, pg8::StaticOrder, false>((PG8_LAS unsigned char*)lds, g, S, E, nullptr); } }
    SYNC_AFTER(2);
    if (RUNS(3)) { { LOADP(); if (PHM & 8) phase3a(P, lds); } __syncthreads(); { LOADP(); if (PHM & 256) phase3b(P, lds); } }
    SYNC_AFTER(3);
    if (RUNS(4)) { LOADP(); if (PHM & 16) phase4(P, lds); }
    SYNC_AFTER(4);
    if (RUNS(5)) { LOADP(); if (PHM & 32) phase5(P); }
    SYNC_AFTER(5);
    if (RUNS(6)) { LOADP(); if (PHM & 64) {
        pg8::Gemm g{P.hbf, P.wt_out, MTOK, D, D}; pg8::StaticOrder S; S.init(MTOK, D, (int)gridDim.x, (int)blockIdx.x);
        EpiOut E{P.out, P.x, P.mod};
        pg8::gemm_phase<EpiOut, pg8::StaticOrder, false>((PG8_LAS unsigned char*)lds, g, S, E, nullptr); } }
    SYNC_AFTER(6);
    if (RUNS(7)) { LOADP(); if (PHM & 128) phase7(P); }
}

#ifndef MULTI_LAUNCH
#define MULTI_LAUNCH 0
#endif
extern "C" void kernel_launch(void* const* d_in, const int* in_sizes, int n_in, void* d_out, int out_size, void* d_ws, size_t ws_size, hipStream_t stream) {
    static int grid = 0;
    if (grid == 0) {
        int dev = 0, cus = 0, per_cu = 0;
        hipGetDevice(&dev); hipDeviceGetAttribute(&cus, hipDeviceAttributeMultiprocessorCount, dev);
        if (hipFuncSetAttribute((const void*)mega, hipFuncAttributeMaxDynamicSharedMemorySize, LDS_BYTES) != hipSuccess) fprintf(stderr, "kernel_launch: hipFuncSetAttribute failed\n");
        if (hipOccupancyMaxActiveBlocksPerMultiprocessor(&per_cu, (const void*)mega, 512, LDS_BYTES) != hipSuccess || per_cu < 1) { fprintf(stderr, "kernel_launch: occupancy query gave %d\n", per_cu); per_cu = 1; }
        (void)hipGetLastError();
        grid = cus * per_cu;
        fprintf(stderr, "kernel_launch: grid %d (%d CUs x %d)\n", grid, cus, per_cu);
    }
    Params P{};
    const float** pin = (const float**)&P.x;
    for (int i = 0; i < 22; ++i) pin[i] = (const float*)d_in[i];
    P.out = (float*)d_out;
    unsigned char* w = (unsigned char*)d_ws; size_t off = 0;
    auto take = [&](size_t bytes) { unsigned char* q = w + off; off += (bytes + 255) & ~(size_t)255; return q; };
    P.mod = (float*)take(8 * 3072 * 4);
    P.hbf = (bf16_t*)take((size_t)MTOK * D * 2);
    P.wt_in = (bf16_t*)take((size_t)NP * D * 2);
    P.wt_out = (bf16_t*)take((size_t)D * D * 2);
    P.wupT = (bf16_t*)take(512 * 64 * 2);
    P.aupT = (bf16_t*)take(512 * 64 * 2);
    P.p = (bf16_t*)take((size_t)MTOK * NP * 2);
    P.sr = (bf16_t*)take((size_t)MTOK * 512 * 2); P.sk = (bf16_t*)take((size_t)MTOK * 512 * 2); P.sv = (bf16_t*)take((size_t)MTOK * 512 * 2);
    P.skk = (bf16_t*)take((size_t)MTOK * 512 * 2); P.sb = (bf16_t*)take((size_t)MTOK * 512 * 2);
    P.y = (float*)d_out; P.slw = (float*)d_out + (size_t)MTOK * 512;
    if (off > ws_size) { fprintf(stderr, "kernel_launch: workspace too small (%zu > %zu)\n", off, ws_size); return; }
#if MULTI_LAUNCH
    for (int ph = 0; ph < NPHASE; ++ph) { P.phase_lo = ph; P.phase_hi = ph + 1; hipLaunchKernelGGL(mega, dim3(grid), dim3(512), LDS_BYTES, stream, P); }
#else
    P.phase_lo = 0; P.phase_hi = NPHASE;
    void* args[] = {&P};
    hipError_t e = hipLaunchCooperativeKernel((const void*)mega, dim3(grid), dim3(512), args, LDS_BYTES, stream);
    if (e != hipSuccess) fprintf(stderr, "kernel_launch: cooperative launch failed: %s (grid %d)\n", hipGetErrorString(e), grid);
#endif
}
```

```cpp
#include <hip/hip_runtime.h>
#include <hip/hip_cooperative_groups.h>
#include <cstdio>
namespace cg = cooperative_groups;
namespace pg8 {
#define PG8_LAS __attribute__((address_space(3)))
typedef unsigned short bf16_t;
typedef short bf16x8 __attribute__((ext_vector_type(8)));
typedef float f32x4 __attribute__((ext_vector_type(4)));
typedef unsigned u32x4 __attribute__((ext_vector_type(4)));
constexpr int BM = 256, BK = 64, HALF = 128, HTB = HALF * BK * 2  , STAGE_BYTES = 8 * HTB, NXCD = 8, WGM = 4;

__host__ __device__ __forceinline__ int lds_byte(int r, int c) { const int st = (r >> 4) * 2 + (c >> 5), rr = r & 15, cc = c & 31, ob = rr * 64 + cc * 2; return st * 1024 + (ob ^ (((ob >> 9) & 1) << 5)); }
__host__ __device__ __forceinline__ void stage_rc(int b, int& R, int& C) { const int st = b / 1024, sb = b % 1024, swz = sb ^ (((sb >> 9) & 1) << 5); R = (st >> 1) * 16 + swz / 64; C = (st & 1) * 32 + (swz % 64) / 2; }
__host__ __device__ __forceinline__ int perm32(int rho) { const int n = rho >> 4, i = rho & 15; return 8 * (i >> 2) + 4 * n + (i & 3); }

struct Unit { int pm, pn; };
struct Gemm { const bf16_t* A; const bf16_t* Bt; int M, N, K; };

struct StaticOrder {
    int nM, nN, nwg, G, c, wgm;
    __host__ __device__ void init(int M, int N, int G_, int c_, int wgm_ = WGM) { nM = M / BM; nN = N / BM; nwg = nM * nN; G = G_; c = c_; wgm = wgm_; }
    __host__ __device__ bool next(int i, Unit& u) const {
        const long L = (long)i * G + c; if (L >= nwg) return false;
        int wgid = (int)L; { const int q = nwg / NXCD, r = nwg % NXCD, xcd = wgid % NXCD, off = wgid / NXCD; wgid = (xcd < r ? xcd * (q + 1) : r * (q + 1) + (xcd - r) * q) + off; }
        const int nig = wgm * nN, gid = wgid / nig, fm = gid * wgm, gsz = (nM - fm) < wgm ? (nM - fm) : wgm;
        u.pm = fm + ((wgid % nig) % gsz); u.pn = (wgid % nig) / gsz; return true;
    }
    __device__ __forceinline__ void a_ready(const Unit&) const {}
    __device__ __forceinline__ void done(const Unit&) const {}
};

__device__ __forceinline__ unsigned cvt_pk_bf16(float lo, float hi) { unsigned r; asm volatile("v_cvt_pk_bf16_f32 %0, %1, %2" : "=v"(r) : "v"(lo), "v"(hi)); return r; }
typedef float f32x2 __attribute__((ext_vector_type(2)));
__device__ __forceinline__ f32x2 gelu_pk(f32x2 v) {
    const f32x2 av = __builtin_elementwise_abs(v), d = av * 0.2316418882f + 1.0f;
    f32x2 t; t.x = __builtin_amdgcn_rcpf(d.x); t.y = __builtin_amdgcn_rcpf(d.y);
    f32x2 q = t * 0.5307027145f + (-0.7265760135f); q = q * t + 0.7107068705f; q = q * t + (-0.142248368f); q = q * t + 0.127414796f; q = q * t;
    const f32x2 s = (v * v) * (-0.72134752044f);
    f32x2 e; e.x = __builtin_amdgcn_exp2f(s.x); e.y = __builtin_amdgcn_exp2f(s.y);
    const f32x2 m = v * (q * e), r = v - m;
    f32x2 o; o.x = v.x < 0.f ? m.x : r.x; o.y = v.y < 0.f ? m.y : r.y; return o;
}

struct EpiF32 {
    static constexpr bool PERM = false, AFTER_DRAIN = false;
    float* C; int ldc; const float* bias;
    __device__ __forceinline__ void operator()(const f32x4 (&acc)[2][2][4][2], const Unit& u, int wr, int wc, int fr, int fq) const {
        const int row0 = u.pm * BM + wr * 64 + fr, col0 = u.pn * BM + wc * 32 + 4 * fq;
        f32x4 bv[2][2];
#pragma unroll
        for (int bj = 0; bj < 2; ++bj)
#pragma unroll
            for (int n = 0; n < 2; ++n) bv[bj][n] = bias ? *(const f32x4*)(bias + col0 + bj * HALF + n * 16) : (f32x4){0.f, 0.f, 0.f, 0.f};
#pragma unroll
        for (int ai = 0; ai < 2; ++ai)
#pragma unroll
            for (int m = 0; m < 4; ++m) { float* rowp = C + (size_t)(row0 + ai * HALF + m * 16) * ldc + col0;
#pragma unroll
                for (int bj = 0; bj < 2; ++bj)
#pragma unroll
                    for (int n = 0; n < 2; ++n) *(f32x4*)(rowp + bj * HALF + n * 16) = acc[ai][bj][m][n] + bv[bj][n]; }
    }
};
template <int ACT  > struct EpiBf16 {
    static constexpr bool PERM = true, AFTER_DRAIN = false;
    bf16_t* O; int ldc; const float* bias; int split_cols; size_t split_stride;
    __device__ __forceinline__ void operator()(const f32x4 (&acc)[2][2][4][2], const Unit& u, int wr, int wc, int fr, int fq) const {
        const int row0 = u.pm * BM + wr * 64 + fr; int colt = u.pn * BM; bf16_t* base = O;
        if (split_cols) { const int t = colt / split_cols; base += (size_t)t * split_stride; colt -= t * split_cols; }
        const int col0 = colt + wc * 32 + 8 * fq, bcol0 = u.pn * BM + wc * 32 + 8 * fq;
        f32x4 bv[2][2];
#pragma unroll
        for (int bj = 0; bj < 2; ++bj)
#pragma unroll
            for (int n = 0; n < 2; ++n) bv[bj][n] = bias ? *(const f32x4*)(bias + bcol0 + bj * HALF + 4 * n) : (f32x4){0.f, 0.f, 0.f, 0.f};
#pragma unroll
        for (int ai = 0; ai < 2; ++ai)
#pragma unroll
            for (int m = 0; m < 4; ++m) { bf16_t* rowp = base + (size_t)(row0 + ai * HALF + m * 16) * ldc + col0;
#pragma unroll
                for (int bj = 0; bj < 2; ++bj) { f32x4 v0 = acc[ai][bj][m][0] + bv[bj][0], v1 = acc[ai][bj][m][1] + bv[bj][1];
                    if (ACT == 1) { f32x2 a = gelu_pk((f32x2){v0[0], v0[1]}), b = gelu_pk((f32x2){v0[2], v0[3]}), c = gelu_pk((f32x2){v1[0], v1[1]}), d = gelu_pk((f32x2){v1[2], v1[3]});
                        v0 = (f32x4){a.x, a.y, b.x, b.y}; v1 = (f32x4){c.x, c.y, d.x, d.y}; }
                    if (ACT == 2) {
#pragma unroll
                        for (int j = 0; j < 4; ++j) { v0[j] = 0.5f * v0[j] * (1.0f + erff(v0[j] * 0.70710678f)); v1[j] = 0.5f * v1[j] * (1.0f + erff(v1[j] * 0.70710678f)); } }
                    u32x4 w; w.x = cvt_pk_bf16(v0[0], v0[1]); w.y = cvt_pk_bf16(v0[2], v0[3]); w.z = cvt_pk_bf16(v1[0], v1[1]); w.w = cvt_pk_bf16(v1[2], v1[3]);
                    *(u32x4*)(rowp + bj * HALF) = w; } }
    }
};

template <class Epi, class Sched, bool STAMP = false>
__device__ __forceinline__ void gemm_phase(PG8_LAS unsigned char* lds, const Gemm g, const Sched& S, const Epi& E, unsigned long long* stamps) {
    const int tid = threadIdx.x, wid = __builtin_amdgcn_readfirstlane(tid >> 6), lane = tid & 63, wr = wid >> 2, wc = wid & 3, fr = lane & 15, fq = lane >> 4;
    const int K = g.K, nt = K / BK;
    int ts_lo = 0, ts_hi = 0, nts = 0; const unsigned long long rt_entry = STAMP ? (unsigned long long)wall_clock64() : 0ull;
#define PG8_STAMP() do { if (STAMP && wid == 0 && nts < 64) { const unsigned long long _c = (unsigned long long)clock64(); \
        ts_lo = (lane == nts) ? (int)(unsigned)_c : ts_lo; ts_hi = (lane == nts) ? (int)(unsigned)(_c >> 32) : ts_hi; ++nts; } } while (0)
    PG8_STAMP();
    unsigned voffA[2], voffB[2];
#pragma unroll
    for (int i = 0; i < 2; ++i) { int R, C; stage_rc(tid * 16 + i * 8192, R, C); const int Rb = Epi::PERM ? ((R & ~31) + perm32(R & 31)) : R;
        voffA[i] = (unsigned)(R * K + C) * 2u; voffB[i] = (unsigned)(Rb * K + C) * 2u; }
    const size_t kstep = (size_t)(BK * 2);
    const size_t hstep = (size_t)HALF * K * 2;
    const size_t tstep = 2 * hstep;
    const unsigned ldsw = (unsigned)wid * 1024u;
    const int aoff = lds_byte(wr * 64 + fr, fq * 8), boff = lds_byte(wc * 32 + fr, fq * 8);
#define PG8_SA(b, h) (((b) * 2 + (h)) * HTB)
#define PG8_SB(b, h) ((4 + (b) * 2 + (h)) * HTB)
#define PG8_STAGE(bufoff, gbase, voff) do { _Pragma("unroll") for (int _i = 0; _i < 2; ++_i) \
        __builtin_amdgcn_global_load_lds((const unsigned*)((const char*)(gbase) + (voff)[_i]), (PG8_LAS unsigned*)(lds + (bufoff) + ldsw + _i * 8192), 16, 0, 0); } while (0)
#define PG8_LDA(dst, b, h) do { _Pragma("unroll") for (int m = 0; m < 4; ++m) _Pragma("unroll") for (int k = 0; k < 2; ++k) dst[m][k] = *(const PG8_LAS bf16x8*)(lds + PG8_SA(b, h) + aoff + m * 2048 + k * 1024); } while (0)
#define PG8_LDB(dst, b, h) do { _Pragma("unroll") for (int n = 0; n < 2; ++n) _Pragma("unroll") for (int k = 0; k < 2; ++k) dst[n][k] = *(const PG8_LAS bf16x8*)(lds + PG8_SB(b, h) + boff + n * 2048 + k * 1024); } while (0)
#define PG8_MMA(ai, bj, At, Bt) do { __builtin_amdgcn_s_setprio(1); _Pragma("unroll") for (int m = 0; m < 4; ++m) _Pragma("unroll") for (int n = 0; n < 2; ++n) _Pragma("unroll") for (int k = 0; k < 2; ++k) \
        acc[ai][bj][m][n] = __builtin_amdgcn_mfma_f32_16x16x32_bf16(Bt[n][k], At[m][k], acc[ai][bj][m][n], 0, 0, 0); __builtin_amdgcn_s_setprio(0); } while (0)
#define PG8_WAIT_V(n) asm volatile("s_waitcnt vmcnt(" #n ")" ::: "memory")
#define PG8_WAIT_L(n) asm volatile("s_waitcnt lgkmcnt(" #n ")" ::: "memory")
#define PG8_BAR __builtin_amdgcn_s_barrier()
#define PG8_SCHED __builtin_amdgcn_sched_barrier(0)
    Unit cur, nxt; int ui = 0;
    if (!S.next(0, cur)) return;
    f32x4 acc[2][2][4][2];
#pragma unroll
    for (int a = 0; a < 2; ++a)
#pragma unroll
        for (int b = 0; b < 2; ++b)
#pragma unroll
            for (int m = 0; m < 4; ++m)
#pragma unroll
                for (int n = 0; n < 2; ++n) acc[a][b][m][n] = (f32x4){0.f, 0.f, 0.f, 0.f};
    bf16x8 At[4][2], B0[2][2], B1[2][2];
    const char* cA = (const char*)g.A + (size_t)cur.pm * tstep; const char* cB = (const char*)g.Bt + (size_t)cur.pn * tstep;
    S.a_ready(cur);
    PG8_STAGE(PG8_SB(0, 0), cB, voffB); PG8_STAGE(PG8_SA(0, 0), cA, voffA); PG8_STAGE(PG8_SB(0, 1), cB + hstep, voffB); PG8_STAGE(PG8_SA(0, 1), cA + hstep, voffA);
    if (wr == 1) PG8_BAR;
    PG8_WAIT_V(4); PG8_BAR;
    PG8_STAGE(PG8_SB(1, 0), cB + kstep, voffB); PG8_STAGE(PG8_SA(1, 0), cA + kstep, voffA); PG8_STAGE(PG8_SB(1, 1), cB + hstep + kstep, voffB);
    PG8_WAIT_V(6); PG8_BAR;
    PG8_STAMP();
    for (;;) {
        const bool has_next = S.next(ui + 1, nxt);
        const char* nA = has_next ? (const char*)g.A + (size_t)nxt.pm * tstep : cA; const char* nB = has_next ? (const char*)g.Bt + (size_t)nxt.pn * tstep : cB;
        for (int t = 0; t < nt; t += 2) {
            const bool last = (t == nt - 2);
            const char* a1 = cA + (size_t)(t + 1) * kstep;
            const char* a2 = last ? nA : cA + (size_t)(t + 2) * kstep; const char* b2 = last ? nB : cB + (size_t)(t + 2) * kstep;
            const char* a3 = a2 + kstep; const char* b3 = b2 + kstep;
            if (last && has_next) S.a_ready(nxt);
            PG8_LDB(B0, 0, 0); PG8_SCHED; PG8_LDA(At, 0, 0); PG8_STAGE(PG8_SA(1, 1), a1 + hstep, voffA);
            PG8_WAIT_L(8); PG8_BAR; PG8_WAIT_L(0); PG8_MMA(0, 0, At, B0); PG8_BAR; PG8_SCHED;
            PG8_LDB(B1, 0, 1); PG8_STAGE(PG8_SB(0, 0), b2, voffB);
            PG8_BAR; PG8_WAIT_L(0); PG8_MMA(0, 1, At, B1); PG8_BAR;
            PG8_LDA(At, 0, 1); PG8_STAGE(PG8_SA(0, 0), a2, voffA);
            PG8_BAR; PG8_WAIT_L(0); PG8_MMA(1, 0, At, B0); PG8_BAR; PG8_SCHED;
            PG8_STAGE(PG8_SB(0, 1), b2 + hstep, voffB);
            PG8_WAIT_V(6); PG8_BAR; PG8_MMA(1, 1, At, B1); PG8_BAR;
            PG8_LDB(B0, 1, 0); PG8_SCHED; PG8_LDA(At, 1, 0); PG8_STAGE(PG8_SA(0, 1), a2 + hstep, voffA);
            PG8_WAIT_L(8); PG8_BAR; PG8_WAIT_L(0); PG8_MMA(0, 0, At, B0); PG8_BAR; PG8_SCHED;
            PG8_LDB(B1, 1, 1); PG8_STAGE(PG8_SB(1, 0), b3, voffB);
            PG8_BAR; PG8_WAIT_L(0); PG8_MMA(0, 1, At, B1); PG8_BAR;
            PG8_LDA(At, 1, 1); PG8_STAGE(PG8_SA(1, 0), a3, voffA);
            PG8_BAR; PG8_WAIT_L(0); PG8_MMA(1, 0, At, B0); PG8_BAR; PG8_SCHED;
            PG8_STAGE(PG8_SB(1, 1), b3 + hstep, voffB);
            PG8_WAIT_V(6); PG8_BAR; PG8_MMA(1, 1, At, B1); PG8_BAR;
        }
        PG8_STAMP();
        if constexpr (!Epi::AFTER_DRAIN) { E(acc, cur, wr, wc, fr, fq); S.done(cur); }
        PG8_STAMP();
        if (!has_next) break;
#pragma unroll
        for (int a = 0; a < 2; ++a)
#pragma unroll
            for (int b = 0; b < 2; ++b)
#pragma unroll
                for (int m = 0; m < 4; ++m)
#pragma unroll
                    for (int n = 0; n < 2; ++n) acc[a][b][m][n] = (f32x4){0.f, 0.f, 0.f, 0.f};
        cur = nxt; cA = nA; cB = nB; ++ui;
    }
    PG8_WAIT_V(0);
    if (wr == 0) PG8_BAR;
    PG8_BAR;
    if constexpr (Epi::AFTER_DRAIN) { E.fused(acc, cur, wr, wc, fr, fq, lds, wid, lane); S.done(cur); }
    PG8_STAMP();
    if (STAMP && wid == 0) { stamps[lane] = lane < nts ? (((unsigned long long)(unsigned)ts_hi << 32) | (unsigned)ts_lo) : 0ull;
        if (lane == 62) stamps[62] = rt_entry; if (lane == 63) stamps[63] = (unsigned long long)wall_clock64(); }
#undef PG8_STAMP
#undef PG8_SA
#undef PG8_SB
#undef PG8_STAGE
#undef PG8_LDA
#undef PG8_LDB
#undef PG8_MMA
#undef PG8_WAIT_V
#undef PG8_WAIT_L
#undef PG8_BAR
#undef PG8_SCHED
}
}
#ifndef WGM_MAIN
#define WGM_MAIN 4
#endif
#ifndef WGM_OUT
#define WGM_OUT 4
#endif

constexpr int D = 1024, NB = 8, T = 4096, MTOK = NB * T;
constexpr int NP = 3840;
constexpr int CA_U = 0, CA_V = 512, CA_G = 1024;
constexpr int CB0 = 1536;
constexpr int CB_R = 0, CB_K = 512, CB_V = 1024, CB_G = 1536, CB_WD = 2048;
constexpr float ALPHA = 1.189207115f;
constexpr float LN_EPS = 1e-5f, GN_EPS = 64e-5f;
constexpr int XB_LDS_OFF = 160256;
constexpr int LDS_BYTES = 160256 + 16;

typedef unsigned short bf16_t;
typedef short bf16x8 __attribute__((ext_vector_type(8)));
typedef float f32x4 __attribute__((ext_vector_type(4)));
typedef float f32x2 __attribute__((ext_vector_type(2)));
typedef float f32x16 __attribute__((ext_vector_type(16)));
typedef unsigned u32x4 __attribute__((ext_vector_type(4)));
typedef unsigned u32x2 __attribute__((ext_vector_type(2)));
#define DI __device__ __forceinline__
#define MFMA32(a, b, c) __builtin_amdgcn_mfma_f32_32x32x16_bf16((a), (b), (c), 0, 0, 0)

DI float bf2f(bf16_t v) { return __uint_as_float(((unsigned)v) << 16); }
DI float bflo(unsigned w) { return __uint_as_float(w << 16); }
DI float bfhi(unsigned w) { return __uint_as_float(w & 0xffff0000u); }
typedef __bf16 bf16x2_t __attribute__((ext_vector_type(2)));
DI unsigned pk2(float lo, float hi) { const f32x2 v = {lo, hi}; return __builtin_bit_cast(unsigned, __builtin_convertvector(v, bf16x2_t)); }
DI bf16_t f2bf(float f) { return (bf16_t)(pk2(f, f) & 0xffffu); }
#define LBAR() asm volatile("s_waitcnt lgkmcnt(0)\n\ts_barrier" ::: "memory")
DI float rcpf_(float x) { return __builtin_amdgcn_rcpf(x); }
DI float sigm(float x) { return rcpf_(1.f + __expf(-x)); }
DI float silu(float x) { return x * rcpf_(1.f + __expf(-x)); }
DI float gelu_tanh(float x) { const float u = 1.5957691216f * (x + 0.044715f * x * x * x); return x * rcpf_(1.f + __expf(-u)); }
DI int crow(int reg, int h) { return (reg & 3) + 8 * (reg >> 2) + 4 * h; }
template <int CTRL> DI float dppf(float x) { return __int_as_float(__builtin_amdgcn_update_dpp(0, __float_as_int(x), CTRL, 0xF, 0xF, true)); }
DI float reduce16(float x) { x += dppf<0xB1>(x); x += dppf<0x4E>(x); x += dppf<0x141>(x); x += dppf<0x140>(x); return x; }
DI float reduce32(float x) { x = reduce16(x); x += __shfl_xor(x, 16); return x; }

struct Params {
    const float *x, *c, *w_ada, *b_ada, *w_in, *mu_b, *ln_v_g, *ln_v_b, *w_spatial, *b_spatial, *w0, *w_up, *a0, *a_up, *k_k, *k_a, *r_k, *gn_g, *gn_b, *w_out, *ln_g, *ln_b;
    float* out;
    float* mod;
    bf16_t* hbf;
    bf16_t* wt_in;
    bf16_t* wt_out;
    bf16_t* wupT;
    bf16_t* aupT;
    bf16_t* p;
    bf16_t *An, *Bn, *Kn, *Rn, *At, *Bt, *Kt, *Vt;
    bf16_t *sv, *sg;
    float *gC, *bonus;
    bf16_t *cG, *cR;
    bf16_t *cH, *cY;
    bf16_t* cS;
    float* y;
    bf16_t* pre;
    unsigned* xbar;
    int phase_lo, phase_hi;
};

DI void tr_tile(const float* src, int ld, int ncols, bf16_t* dst, int ldd, int kt, int nt, float* red) {
    const int tid = threadIdx.x, kr = tid >> 3, c8 = (tid & 7) * 8, n0 = nt * 64;
    f32x4 a = {0.f, 0.f, 0.f, 0.f}, b = a;
    if (n0 + c8 < ncols) { const float* s = src + (size_t)(kt * 64 + kr) * ld + n0 + c8; a = *(const f32x4*)s; b = *(const f32x4*)(s + 4); }
    float* tr = red + kr * 65 + c8;
    tr[0] = a[0]; tr[1] = a[1]; tr[2] = a[2]; tr[3] = a[3]; tr[4] = b[0]; tr[5] = b[1]; tr[6] = b[2]; tr[7] = b[3];
    __syncthreads();
    const int n = tid >> 3, kgp = (tid & 7) * 8;
    u32x4 w;
    w.x = pk2(red[(kgp + 0) * 65 + n], red[(kgp + 1) * 65 + n]); w.y = pk2(red[(kgp + 2) * 65 + n], red[(kgp + 3) * 65 + n]);
    w.z = pk2(red[(kgp + 4) * 65 + n], red[(kgp + 5) * 65 + n]); w.w = pk2(red[(kgp + 6) * 65 + n], red[(kgp + 7) * 65 + n]);
    *(u32x4*)(dst + (size_t)(n0 + n) * ldd + kt * 64 + kgp) = w;
    __syncthreads();
}
__device__ void phase0(const Params& P, unsigned char* lds) {
    float* sc = (float*)lds;
    float* red = sc + 8192;
    const int tid = threadIdx.x;
    for (int i = tid; i < 8192; i += 512) sc[i] = silu(P.c[i]);
    __syncthreads();
    constexpr int NMOD = 192, NTIN = 960, NTOUT = 256, NTUP = 16;
    for (int it = blockIdx.x; it < NMOD + NTIN + NTOUT + NTUP; it += gridDim.x) {
        if (it < NMOD) {
            const int cl = tid & 15, n = it * 16 + cl, kg = tid >> 4;
            float acc[8];
#pragma unroll
            for (int b = 0; b < 8; ++b) acc[b] = 0.f;
            for (int i = 0; i < 32; ++i) {
                const int k = kg + 32 * i; const float w = P.w_ada[(size_t)k * 3072 + n];
#pragma unroll
                for (int b = 0; b < 8; ++b) acc[b] += sc[b * 1024 + k] * w;
            }
#pragma unroll
            for (int b = 0; b < 8; ++b) red[(kg * 16 + cl) * 8 + b] = acc[b];
            __syncthreads();
            if (tid < 128) { const int b = tid >> 4, c2 = tid & 15; float s = 0.f; for (int g = 0; g < 32; ++g) s += red[(g * 16 + c2) * 8 + b];
                P.mod[b * 3072 + it * 16 + c2] = s + P.b_ada[it * 16 + c2]; }
            __syncthreads();
        } else {
            int j = it - NMOD;
            if (j < NTIN) tr_tile(P.w_in, 3712, 3712, P.wt_in, 1024, j & 15, j >> 4, red);
            else if (j < NTIN + NTOUT) { j -= NTIN; tr_tile(P.w_out, 1024, 1024, P.wt_out, 1024, j & 15, j >> 4, red); }
            else if (j < NTIN + NTOUT + 8) { j -= NTIN + NTOUT; tr_tile(P.w_up, 512, 512, P.wupT, 64, 0, j & 7, red); }
            else { j -= NTIN + NTOUT + 8; tr_tile(P.a_up, 512, 512, P.aupT, 64, 0, j & 7, red); }
        }
    }
}

__device__ void phase1(const Params& P) {
    for (size_t idx = (size_t)blockIdx.x * 512 + threadIdx.x; idx < (size_t)MTOK * 128; idx += (size_t)gridDim.x * 512) {
        const int m = (int)(idx >> 7), c8 = (int)(idx & 127) * 8, b = m >> 12;
        const float* xp = P.x + (size_t)m * D + c8; const float* sh = P.mod + b * 3072 + c8; const float* scp = sh + 1024;
        const f32x4 x0 = *(const f32x4*)xp, x1 = *(const f32x4*)(xp + 4), s0 = *(const f32x4*)sh, s1 = *(const f32x4*)(sh + 4), c0 = *(const f32x4*)scp, c1 = *(const f32x4*)(scp + 4);
        const f32x4 h0 = x0 * (1.f + c0) + s0, h1 = x1 * (1.f + c1) + s1;
        u32x4 w; w.x = pk2(h0[0], h0[1]); w.y = pk2(h0[2], h0[3]); w.z = pk2(h1[0], h1[1]); w.w = pk2(h1[2], h1[3]);
        *(u32x4*)(P.hbf + (size_t)m * D + c8) = w;
    }
}

__device__ void phase3a(const Params& P, unsigned char* lds) {
    bf16_t* Wm = (bf16_t*)lds;
    bf16_t* Vt = Wm + 128 * 136;
    bf16_t* UG = Vt + 64 * 136;
    bf16_t* OT = UG + 128 * 72;
    float* BS = (float*)(OT + 128 * 72);
    const int tid = threadIdx.x, wv = tid >> 6, lane = tid & 63, r = lane & 31, h = lane >> 5;
    const int st = tid >> 2, sdq = (tid & 3) * 16;
    int cur_g = -1;
    u32x4 qv[2], qu[2], qg[2];
    auto gload = [&](int it_) { const bf16_t* src = P.p + ((size_t)(it_ >> 3) * 128 + st) * NP + 64 * (it_ & 7) + sdq;
        qv[0] = *(const u32x4*)(src + CA_V); qv[1] = *(const u32x4*)(src + CA_V + 8); qu[0] = *(const u32x4*)(src + CA_U); qu[1] = *(const u32x4*)(src + CA_U + 8);
        qg[0] = *(const u32x4*)(src + CA_G); qg[1] = *(const u32x4*)(src + CA_G + 8); };
    if ((int)blockIdx.x < 2048) gload(blockIdx.x);
    for (int it = blockIdx.x; it < 2048; it += gridDim.x) {
        const int g = it & 7, bc = it >> 3; const size_t row0 = (size_t)bc * 128;
        if (g != cur_g) {
            cur_g = g;
            for (int e = tid; e < 2048; e += 512) {
                const int t = e >> 4, s8 = (e & 15) * 8; const float* sp = P.w_spatial + ((size_t)g * 128 + t) * 128 + s8;
                const f32x4 a = *(const f32x4*)sp, b = *(const f32x4*)(sp + 4);
                float v[8] = {a[0], a[1], a[2], a[3], b[0], b[1], b[2], b[3]};
#pragma unroll
                for (int j = 0; j < 8; ++j) v[j] = (s8 + j <= t) ? v[j] : 0.f;
                *(u32x4*)(Wm + t * 136 + s8) = (u32x4){pk2(v[0], v[1]), pk2(v[2], v[3]), pk2(v[4], v[5]), pk2(v[6], v[7])};
            }
            if (tid < 128) BS[tid] = P.b_spatial[g * 128 + tid];
        }
        {
            const unsigned wq[8] = {qv[0].x, qv[0].y, qv[0].z, qv[0].w, qv[1].x, qv[1].y, qv[1].z, qv[1].w};
            float v[16];
            float s = 0.f;
#pragma unroll
            for (int j = 0; j < 8; ++j) { v[2 * j] = gelu_tanh(bflo(wq[j])); v[2 * j + 1] = gelu_tanh(bfhi(wq[j])); s += v[2 * j] + v[2 * j + 1]; }
            s += dppf<0xB1>(s); s += dppf<0x4E>(s);
            const float mean = s * (1.f / 64.f);
            float q = 0.f;
#pragma unroll
            for (int j = 0; j < 16; ++j) { v[j] -= mean; q += v[j] * v[j]; }
            q += dppf<0xB1>(q); q += dppf<0x4E>(q);
            const float rstd = rsqrtf(q * (1.f / 64.f) + LN_EPS);
#pragma unroll
            for (int j = 0; j < 16; ++j) { const int d = sdq + j; Vt[d * 136 + st] = f2bf(v[j] * rstd * P.ln_v_g[g * 64 + d] + P.ln_v_b[g * 64 + d]); }
            const unsigned wu[8] = {qu[0].x, qu[0].y, qu[0].z, qu[0].w, qu[1].x, qu[1].y, qu[1].z, qu[1].w}, wg[8] = {qg[0].x, qg[0].y, qg[0].z, qg[0].w, qg[1].x, qg[1].y, qg[1].z, qg[1].w};
            unsigned o[8];
#pragma unroll
            for (int j = 0; j < 8; ++j) o[j] = pk2(gelu_tanh(bflo(wu[j])) * silu(bflo(wg[j])), gelu_tanh(bfhi(wu[j])) * silu(bfhi(wg[j])));
            *(u32x4*)(UG + st * 72 + sdq) = (u32x4){o[0], o[1], o[2], o[3]}; *(u32x4*)(UG + st * 72 + sdq + 8) = (u32x4){o[4], o[5], o[6], o[7]};
        }
        __builtin_amdgcn_sched_barrier(0);
        if (it + (int)gridDim.x < 2048) gload(it + gridDim.x);
        LBAR();
        const int t0 = 32 * (wv >> 1), d0 = 32 * (wv & 1);
        f32x16 acc;
#pragma unroll
        for (int i = 0; i < 16; ++i) acc[i] = 0.f;
        for (int ks = 0; ks < 8; ++ks) {
            if (16 * ks > t0 + 31) break;
            const bf16x8 a = *(const bf16x8*)(Wm + (t0 + r) * 136 + 16 * ks + 8 * h);
            const bf16x8 b = *(const bf16x8*)(Vt + (d0 + r) * 136 + 16 * ks + 8 * h);
            acc = MFMA32(a, b, acc);
        }
#pragma unroll
        for (int i = 0; i < 16; ++i) {
            const int t = t0 + crow(i, h), d = d0 + r;
            OT[t * 72 + d] = f2bf((acc[i] + BS[t]) * bf2f(UG[t * 72 + d]));
        }
        LBAR();
        {   const u32x4 o0 = *(const u32x4*)(OT + st * 72 + sdq), o1 = *(const u32x4*)(OT + st * 72 + sdq + 8);
            bf16_t* dst = P.hbf + (row0 + st) * D + 64 * g + sdq;
            *(u32x4*)dst = o0; *(u32x4*)(dst + 8) = o1; }
    }
    LBAR();
}

DI float xs_at(const Params& P, unsigned row, int cb) {
    const unsigned o = row * (unsigned)NP + (unsigned)(CB0 + cb); const float cur = bf2f(P.p[o]);
    const float prev = (row & 4095u) ? bf2f(P.p[o - (unsigned)NP]) : 0.f;
    return cur + P.mu_b[cb] * (prev - cur);
}
__device__ void phase3b(const Params& P, unsigned char* lds) {
    bf16_t* Awd = (bf16_t*)lds;
    bf16_t* Aad = Awd + 64 * 72;
    float* ssn = (float*)(Aad + 64 * 72);
    const int tid = threadIdx.x, wv = tid >> 6, lane = tid & 63, r = lane & 31, h = lane >> 5;
    float* part = ssn + 512 + wv * (64 * 33);
    for (int it = blockIdx.x; it < 512; it += gridDim.x) {
        const size_t m0 = (size_t)it * 64;
        {
            const int t = tid >> 3, c16 = (tid & 7) * 16; const size_t row = m0 + t;
            const bf16_t* q = P.p + row * NP + CB0 + CB_WD + c16; const bool hasprev = (row & 4095) != 0;
            const u32x4 z = {0u, 0u, 0u, 0u};
            const u32x4 c0 = *(const u32x4*)q, c1 = *(const u32x4*)(q + 8);
            const u32x4 p0 = hasprev ? *(const u32x4*)(q - NP) : z, p1 = hasprev ? *(const u32x4*)(q - NP + 8) : z;
            const unsigned cw[8] = {c0.x, c0.y, c0.z, c0.w, c1.x, c1.y, c1.z, c1.w}, pw[8] = {p0.x, p0.y, p0.z, p0.w, p1.x, p1.y, p1.z, p1.w};
            unsigned ow[8];
#pragma unroll
            for (int j = 0; j < 8; ++j) {
                const float m_lo = P.mu_b[CB_WD + c16 + 2 * j], m_hi = P.mu_b[CB_WD + c16 + 2 * j + 1];
                float lo = bflo(cw[j]), hi = bfhi(cw[j]);
                lo += m_lo * (bflo(pw[j]) - lo); hi += m_hi * (bfhi(pw[j]) - hi);
                if (c16 < 64) { lo = tanhf(lo); hi = tanhf(hi); }
                ow[j] = pk2(lo, hi);
            }
            bf16_t* dst = (c16 < 64) ? (Awd + t * 72 + c16) : (Aad + t * 72 + (c16 - 64));
            *(u32x4*)dst = (u32x4){ow[0], ow[1], ow[2], ow[3]}; *(u32x4*)(dst + 8) = (u32x4){ow[4], ow[5], ow[6], ow[7]};
        }
#pragma unroll 2
        for (int rd = 0; rd < 16; ++rd) {
            const int pair = rd * 32 + (tid >> 4), t = pair >> 3, hd = pair & 7, l16 = tid & 15, n = hd * 64 + l16 * 4; const unsigned row = (unsigned)m0 + t;
            const unsigned o = row * (unsigned)NP + (unsigned)(CB0 + CB_K + n);
            const u32x2 cu = *(const u32x2*)(P.p + o); u32x2 pv = {0u, 0u}; if (row & 4095u) pv = *(const u32x2*)(P.p + o - (unsigned)NP);
            const f32x4 mu = *(const f32x4*)(P.mu_b + CB_K + n), kq = *(const f32x4*)(P.k_k + n);
            const float c4[4] = {bflo(cu.x), bfhi(cu.x), bflo(cu.y), bfhi(cu.y)}, p4[4] = {bflo(pv.x), bfhi(pv.x), bflo(pv.y), bfhi(pv.y)};
            float s = 0.f;
#pragma unroll
            for (int j = 0; j < 4; ++j) { const float kk = (c4[j] + mu[j] * (p4[j] - c4[j])) * kq[j]; s += kk * kk; }
            s = reduce16(s);
            if (l16 == 0) ssn[t * 8 + hd] = rsqrtf(s + 1e-12f);
        }
        __syncthreads();
        const int hd = wv;
        const unsigned cbase = (unsigned)(((it >> 6) * 8 + hd) * 64 + (it & 63)) * 4096u;
#pragma unroll 1
        for (int nt = 0; nt < 2; ++nt) {
            const int j = nt * 32 + r, n = hd * 64 + j;
            const float w0n = P.w0[n], a0n = P.a0[n], kkn_ = P.k_k[n], kan = P.k_a[n], rkn = P.r_k[n];
            float run = 0.f;
#pragma unroll 1
            for (int tt = 0; tt < 2; ++tt) {
                f32x16 aw, aa;
#pragma unroll
                for (int i = 0; i < 16; ++i) { aw[i] = 0.f; aa[i] = 0.f; }
#pragma unroll
                for (int ks = 0; ks < 4; ++ks) {
                    const bf16x8 bw = *(const bf16x8*)(P.wupT + (unsigned)((hd * 64 + nt * 32 + r) * 64 + 16 * ks + 8 * h));
                    const bf16x8 ba = *(const bf16x8*)(P.aupT + (unsigned)((hd * 64 + nt * 32 + r) * 64 + 16 * ks + 8 * h));
                    const bf16x8 fw = *(const bf16x8*)(Awd + (tt * 32 + r) * 72 + 16 * ks + 8 * h);
                    const bf16x8 fa = *(const bf16x8*)(Aad + (tt * 32 + r) * 72 + 16 * ks + 8 * h);
                    aw = MFMA32(fw, bw, aw); aa = MFMA32(fa, ba, aa);
                }
#pragma unroll
                for (int i = 0; i < 16; ++i) {
                    const float z = -(w0n + aw[i]);
                    const float sp = fmaxf(z, 0.f) + log1pf(__expf(-fabsf(z)));
                    aw[i] = -__expf(-sp - 0.5f);
                }
                f32x16 cum;
#pragma unroll
                for (int ib = 0; ib < 4; ++ib) {
                    const float l0 = aw[4 * ib], l1 = l0 + aw[4 * ib + 1], l2 = l1 + aw[4 * ib + 2], l3 = l2 + aw[4 * ib + 3];
                    const float pg = __shfl_xor(l3, 32);
                    const float off = run + (h ? pg : 0.f);
                    cum[4 * ib] = off + l0; cum[4 * ib + 1] = off + l1; cum[4 * ib + 2] = off + l2; cum[4 * ib + 3] = off + l3;
                    run += l3 + pg;
                }
#pragma unroll
                for (int ib = 0; ib < 4; ++ib) {
                    float tA[4], tB[4], tK[4], tV[4];
#pragma unroll
                    for (int e = 0; e < 4; ++e) {
                        const int i = 4 * ib + e, t = tt * 32 + 8 * ib + 4 * h + e; const unsigned row = (unsigned)m0 + t;
                        const float xr = xs_at(P, row, CB_R + n), xk = xs_at(P, row, CB_K + n), xv = xs_at(P, row, CB_V + n), xg = xs_at(P, row, CB_G + n);
                        const float a = sigm(a0n + aa[i]);
                        const float kk = xk * kkn_ * ssn[t * 8 + hd];
                        const float kp = xk * (1.f + (a - 1.f) * kan), bq = kk * a;
                        const float ec = cum[i], lw = aw[i];
                        const float gi = __expf(-ec);
                        const float an = -kk * __expf(ec - lw);
                        const unsigned o = cbase + (unsigned)(t * 64 + j);
                        tA[e] = an; tB[e] = bq * gi; tK[e] = kp * gi; tV[e] = xv;
                        P.An[o] = f2bf(an); P.Bn[o] = f2bf(tB[e]); P.Kn[o] = f2bf(tK[e]); P.Rn[o] = f2bf(xr * __expf(ec));
                        P.sv[row * 512u + n] = f2bf(xv); P.sg[row * 512u + n] = f2bf(silu(xg));
                        { float* pp = part + t * 33 + r; const float pv0 = nt ? *pp : 0.f; *pp = pv0 + xr * kp * rkn; }
                    }
                    const unsigned ot = cbase + (unsigned)(j * 64 + tt * 32 + 8 * ib + 4 * h);
                    *(u32x2*)(P.At + ot) = (u32x2){pk2(tA[0], tA[1]), pk2(tA[2], tA[3])};
                    *(u32x2*)(P.Bt + ot) = (u32x2){pk2(tB[0], tB[1]), pk2(tB[2], tB[3])};
                    *(u32x2*)(P.Kt + ot) = (u32x2){pk2(tK[0], tK[1]), pk2(tK[2], tK[3])};
                    *(u32x2*)(P.Vt + ot) = (u32x2){pk2(tV[0], tV[1]), pk2(tV[2], tV[3])};
                    asm volatile("" ::: "memory");
                }
            }
            if (h == 0) P.gC[(cbase >> 6) + j] = __expf(run);
        }
        {
            float s = 0.f;
            for (int q = 0; q < 32; ++q) s += part[lane * 33 + q];
            P.bonus[(m0 + lane) * 8 + hd] = s;
        }
        __syncthreads();
    }
}

DI f32x4 mfma16(bf16x8 a, bf16x8 b, f32x4 c) { return __builtin_amdgcn_mfma_f32_16x16x32_bf16(a, b, c, 0, 0, 0); }
struct TileCtx { int mt, nt0, l16, quad; };
#define FRAG(base, ld, row, ks) (*(const bf16x8*)((base) + (size_t)(row) * (ld) + 32 * (ks) + 8 * c.quad))
#define MM2(acc, A, lda, B, ldb) do { const bf16x8 _a0 = FRAG(A, lda, 16 * c.mt + c.l16, 0), _a1 = FRAG(A, lda, 16 * c.mt + c.l16, 1); \
    _Pragma("unroll") for (int _e = 0; _e < 2; ++_e) { const bf16x8 _b0 = FRAG(B, ldb, 16 * (c.nt0 + _e) + c.l16, 0), _b1 = FRAG(B, ldb, 16 * (c.nt0 + _e) + c.l16, 1); \
        acc[_e] = mfma16(_a0, _b0, acc[_e]); acc[_e] = mfma16(_a1, _b1, acc[_e]); } } while (0)
#define MM2P(acc, A, lda, B, ldb, P0, P1) do { if ((P0) || (P1)) { const bf16x8 _a0 = FRAG(A, lda, 16 * c.mt + c.l16, 0), _a1 = FRAG(A, lda, 16 * c.mt + c.l16, 1); \
    _Pragma("unroll") for (int _e = 0; _e < 2; ++_e) if (_e == 0 ? (P0) : (P1)) { const bf16x8 _b0 = FRAG(B, ldb, 16 * (c.nt0 + _e) + c.l16, 0), _b1 = FRAG(B, ldb, 16 * (c.nt0 + _e) + c.l16, 1); \
        acc[_e] = mfma16(_a0, _b0, acc[_e]); acc[_e] = mfma16(_a1, _b1, acc[_e]); } } } while (0)
DI void storeT_bf(bf16_t* Z, int ld, const TileCtx& c, int e, f32x4 v) { *(u32x2*)(Z + (size_t)(16 * (c.nt0 + e) + c.l16) * ld + 16 * c.mt + 4 * c.quad) = (u32x2){pk2(v[0], v[1]), pk2(v[2], v[3])}; }
DI void storeN_bf(bf16_t* Z, int ld, const TileCtx& c, int e, f32x4 v) {
#pragma unroll
    for (int jj = 0; jj < 4; ++jj) Z[(size_t)(16 * c.mt + 4 * c.quad + jj) * ld + 16 * (c.nt0 + e) + c.l16] = f2bf(v[jj]); }
DI f32x4 loadT_bf(const bf16_t* Z, int ld, const TileCtx& c, int e) { const u32x2 w = *(const u32x2*)(Z + (size_t)(16 * (c.nt0 + e) + c.l16) * ld + 16 * c.mt + 4 * c.quad); return (f32x4){bflo(w.x), bfhi(w.x), bflo(w.y), bfhi(w.y)}; }
constexpr int LQ = 72, LMB = 64 * LQ;
template <int KLEN> DI f32x4 mm1(f32x4 acc, const bf16_t* A, int arow, const bf16_t* B, int brow, int koff, int l16, int quad) {
    const bf16x8 zz = {0, 0, 0, 0, 0, 0, 0, 0};
    bf16x8 a = zz, b = zz;
    if (KLEN == 32 || quad < 2) { a = *(const bf16x8*)(A + (arow + l16) * LQ + koff + 8 * quad); b = *(const bf16x8*)(B + (brow + l16) * LQ + koff + 8 * quad); }
    return mfma16(a, b, acc);
}
DI void st1T(bf16_t* Z, int mrow, int nrow, int l16, int quad, f32x4 v) { *(u32x2*)(Z + (nrow + l16) * LQ + mrow + 4 * quad) = (u32x2){pk2(v[0], v[1]), pk2(v[2], v[3])}; }
DI void st1N(bf16_t* Z, int mrow, int nrow, int l16, int quad, f32x4 v) {
#pragma unroll
    for (int jj = 0; jj < 4; ++jj) Z[(mrow + 4 * quad + jj) * LQ + nrow + l16] = f2bf(v[jj]); }
__device__ void phase4a(const Params& P, unsigned char* lds) {
    bf16_t* L0 = (bf16_t*)lds;
    bf16_t *Ma = L0, *Tm = L0 + LMB, *TmT = L0 + 2 * LMB, *Zt = L0 + 3 * LMB;
    bf16_t *Lak = L0 + 6 * LMB, *Lrb = L0 + 7 * LMB, *Lrk = L0 + 8 * LMB, *W2T = L0 + 9 * LMB, *PT = L0 + 10 * LMB, *QT = L0 + 11 * LMB;
    const int tid = threadIdx.x, wv = tid >> 6, lane = tid & 63;
    TileCtx c; c.mt = wv >> 1; c.nt0 = (wv & 1) * 2; c.l16 = lane & 15; c.quad = lane >> 4;
    const f32x4 z = {0.f, 0.f, 0.f, 0.f};
    for (int ci = blockIdx.x; ci < 4096; ci += gridDim.x) {
        const size_t cb = (size_t)ci * 4096;
        const bf16_t *An = P.An + cb, *Bn = P.Bn + cb, *Kn = P.Kn + cb, *Rn = P.Rn + cb, *At = P.At + cb, *Bt = P.Bt + cb, *Kt = P.Kt + cb, *Vt = P.Vt + cb;
        {
            f32x4 ab[2] = {z, z}, ak[2] = {z, z}, rb[2] = {z, z}, rk[2] = {z, z};
            MM2(ab, Bn, 64, An, 64); MM2(ak, Kn, 64, An, 64); MM2(rb, Bn, 64, Rn, 64); MM2(rk, Kn, 64, Rn, 64);
#pragma unroll
            for (int e = 0; e < 2; ++e) {
                const int t = 16 * (c.nt0 + e) + c.l16;
#pragma unroll
                for (int jj = 0; jj < 4; ++jj) { const int s = 16 * c.mt + 4 * c.quad + jj;
                    if (!(s < t)) { ab[e][jj] = 0.f; ak[e][jj] = 0.f; }
                    if (!(s <= t)) { rb[e][jj] = 0.f; rk[e][jj] = 0.f; } }
                storeT_bf(Ma, LQ, c, e, ab[e]);
                storeT_bf(Lak, LQ, c, e, ak[e]); storeT_bf(Lrb, LQ, c, e, rb[e]); storeT_bf(Lrk, LQ, c, e, rk[e]);
            }
        }
        if (tid < 224) {
            const int blk = tid >> 5, rr = (tid >> 1) & 15, hf = tid & 1;
            const int br = blk == 6 ? 1 : (blk < 3 ? 0 : (blk < 5 ? 1 : 2)), bc = blk == 6 ? 0 : (blk < 3 ? blk + 1 : (blk < 5 ? blk - 1 : 3));
            bf16_t* zp = (blk == 6 ? TmT : Tm) + (16 * br + rr) * LQ + 16 * bc + 8 * hf;
            *(u32x4*)zp = (u32x4){0u, 0u, 0u, 0u};
        }
        __syncthreads();
        if (wv == 0) {
            const int d = lane >> 4, cc = lane & 15; float tv[16];
#pragma unroll
            for (int rr = 0; rr < 16; ++rr) {
                const bf16_t* nr = Ma + (16 * d + rr) * LQ + 16 * d; const u32x4 q0 = *(const u32x4*)nr, q1 = *(const u32x4*)(nr + 8);
                const float nv[16] = {bflo(q0.x), bfhi(q0.x), bflo(q0.y), bfhi(q0.y), bflo(q0.z), bfhi(q0.z), bflo(q0.w), bfhi(q0.w), bflo(q1.x), bfhi(q1.x), bflo(q1.y), bfhi(q1.y), bflo(q1.z), bfhi(q1.z), bflo(q1.w), bfhi(q1.w)};
                float a = (rr == cc) ? 1.f : 0.f;
#pragma unroll
                for (int ss = 0; ss < rr; ++ss) a += nv[ss] * tv[ss];
                tv[rr] = a;
                Tm[(16 * d + rr) * LQ + 16 * d + cc] = f2bf(a);
            }
            bf16_t* tr = TmT + (16 * d + cc) * LQ + 16 * d;
            *(u32x4*)tr = (u32x4){pk2(tv[0], tv[1]), pk2(tv[2], tv[3]), pk2(tv[4], tv[5]), pk2(tv[6], tv[7])};
            *(u32x4*)(tr + 8) = (u32x4){pk2(tv[8], tv[9]), pk2(tv[10], tv[11]), pk2(tv[12], tv[13]), pk2(tv[14], tv[15])};
        }
        {
            f32x4 acc[2] = {z, z}; MM2(acc, Lak, LQ, Vt, 64);
#pragma unroll
            for (int e = 0; e < 2; ++e) storeT_bf(W2T, LQ, c, e, acc[e]);
        }
        __syncthreads();
        if (wv < 2) {
            const int lo = 32 * wv, hi = lo + 16;
            const f32x4 a = mm1<16>(z, Ma, hi, TmT, lo, lo, c.l16, c.quad);
            st1T(Zt, hi, lo, c.l16, c.quad, a);
        }
        __syncthreads();
        if (wv < 2) {
            const int lo = 32 * wv, hi = lo + 16;
            const f32x4 a = mm1<16>(z, Tm, hi, Zt, lo, hi, c.l16, c.quad);
            st1N(Tm, hi, lo, c.l16, c.quad, a); st1T(TmT, hi, lo, c.l16, c.quad, a);
        }
        __syncthreads();
        if (wv < 4) {
            const int tb = 32 + 16 * (wv >> 1), ub = 16 * (wv & 1);
            const f32x4 a = mm1<32>(z, Ma, tb, TmT, ub, 0, c.l16, c.quad);
            st1T(Zt, tb, ub, c.l16, c.quad, a);
        }
        __syncthreads();
        if (wv < 4) {
            const int tb = 32 + 16 * (wv >> 1), ub = 16 * (wv & 1);
            const f32x4 a = mm1<32>(z, Zt, ub, Tm, tb, 32, c.l16, c.quad);
            st1T(Tm, ub, tb, c.l16, c.quad, a);
        }
        __syncthreads();
        {
            f32x4 ap[2] = {z, z}, aq[2] = {z, z};
            MM2(ap, Tm, LQ, At, 64); MM2(aq, Tm, LQ, W2T, LQ);
#pragma unroll
            for (int e = 0; e < 2; ++e) { storeT_bf(PT, LQ, c, e, ap[e]); storeT_bf(QT, LQ, c, e, aq[e]); }
        }
        __syncthreads();
        {
            f32x4 ar[2] = {z, z}, ag[2] = {z, z}, ay[2] = {z, z}, ah[2] = {z, z};
            MM2(ar, PT, LQ, Lrb, LQ);
            MM2(ag, PT, LQ, Bt, 64);
            MM2(ay, Lrb, LQ, QT, LQ); MM2(ay, Lrk, LQ, Vt, 64);
            MM2(ah, Bt, 64, QT, LQ); MM2(ah, Kt, 64, Vt, 64);
#pragma unroll
            for (int e = 0; e < 2; ++e) {
                const int n = 16 * (c.nt0 + e) + c.l16, m0 = 16 * c.mt + 4 * c.quad; const size_t o = cb + (size_t)n * 64 + m0;
                const f32x4 rr = loadT_bf(Rn, 64, c, e) + ar[e];
                *(u32x2*)(P.cR + o) = (u32x2){pk2(rr[0], rr[1]), pk2(rr[2], rr[3])};
                const float gc = P.gC[(size_t)ci * 64 + n];
                f32x4 gg = ag[e];
#pragma unroll
                for (int jj = 0; jj < 4; ++jj) gg[jj] = gc * (gg[jj] + (m0 + jj == n ? 1.f : 0.f));
                *(u32x2*)(P.cG + o) = (u32x2){pk2(gg[0], gg[1]), pk2(gg[2], gg[3])};
                *(f32x4*)(P.cY + o) = ay[e];
                *(f32x4*)(P.cH + o) = ah[e] * *(const f32x4*)(P.gC + (size_t)ci * 64 + m0);
            }
        }
        __syncthreads();
    }
}

constexpr int FS_AWD = 12 * LMB * 2, FS_AAD = FS_AWD + LMB * 2, FS_WU = FS_AAD + LMB * 2, FS_AU = FS_WU + LMB * 2, FS_MISC = FS_AU + LMB * 2;
constexpr int FUSED_LDS = FS_MISC + 4096;
__device__ void phaseF(const Params& P, unsigned char* lds) {
    bf16_t* L0 = (bf16_t*)lds;
    bf16_t *sAn = L0, *sBn = L0 + LMB, *sKn = L0 + 2 * LMB, *sRn = L0 + 3 * LMB, *sAt = L0 + 4 * LMB, *sBt = L0 + 5 * LMB, *sKt = L0 + 6 * LMB, *sVt = L0 + 7 * LMB;
    bf16_t *Ma = L0 + 8 * LMB, *Lak = L0 + 9 * LMB, *Lrb = L0 + 10 * LMB, *Lrk = L0 + 11 * LMB;
    bf16_t *Tm = sAn, *TmT = sBn, *W2T = sKn, *Zt = Lak, *PT = Ma, *QT = sBn;
    float* LW = (float*)(L0 + 8 * LMB);
    float* XK = (float*)(L0 + 10 * LMB);
    bf16_t* Awd = (bf16_t*)(lds + FS_AWD); bf16_t* Aad = (bf16_t*)(lds + FS_AAD); bf16_t* WU = (bf16_t*)(lds + FS_WU); bf16_t* AU = (bf16_t*)(lds + FS_AU);
    float* ssn = (float*)(lds + FS_MISC);
    float* BP = ssn + 64;
    float* gCl = BP + 128;
    float* SEG = gCl + 64;
    const int tid = threadIdx.x, wv = tid >> 6, lane = tid & 63;
    TileCtx c; c.mt = wv >> 1; c.nt0 = (wv & 1) * 2; c.l16 = lane & 15; c.quad = lane >> 4;
    const f32x4 z = {0.f, 0.f, 0.f, 0.f};
    float* MU = (float*)(lds + FS_MISC + 4096);
    for (int i = tid; i < 2176; i += 512) MU[i] = P.mu_b[i];
    for (int grp = blockIdx.x; grp < 512; grp += gridDim.x) {
        const unsigned m0 = (unsigned)grp * 64u;
        {
            const int t = tid >> 3, c16 = (tid & 7) * 16; const unsigned row = m0 + t;
            const bf16_t* q = P.p + (size_t)row * NP + CB0 + CB_WD + c16; const bool hasprev = (row & 4095u) != 0;
            const u32x4 zz = {0u, 0u, 0u, 0u};
            const u32x4 c0 = *(const u32x4*)q, c1 = *(const u32x4*)(q + 8);
            const u32x4 p0 = hasprev ? *(const u32x4*)(q - NP) : zz, p1 = hasprev ? *(const u32x4*)(q - NP + 8) : zz;
            const unsigned cw[8] = {c0.x, c0.y, c0.z, c0.w, c1.x, c1.y, c1.z, c1.w}, pw[8] = {p0.x, p0.y, p0.z, p0.w, p1.x, p1.y, p1.z, p1.w};
            unsigned ow[8];
#pragma unroll
            for (int j = 0; j < 8; ++j) {
                const float m_lo = P.mu_b[CB_WD + c16 + 2 * j], m_hi = P.mu_b[CB_WD + c16 + 2 * j + 1];
                float lo = bflo(cw[j]), hi = bfhi(cw[j]);
                lo += m_lo * (bflo(pw[j]) - lo); hi += m_hi * (bfhi(pw[j]) - hi);
                if (c16 < 64) { lo = 1.f - 2.f * rcpf_(1.f + __expf(2.f * lo)); hi = 1.f - 2.f * rcpf_(1.f + __expf(2.f * hi)); }
                ow[j] = pk2(lo, hi);
            }
            bf16_t* dst = (c16 < 64) ? (Awd + t * LQ + c16) : (Aad + t * LQ + (c16 - 64));
            *(u32x4*)dst = (u32x4){ow[0], ow[1], ow[2], ow[3]}; *(u32x4*)(dst + 8) = (u32x4){ow[4], ow[5], ow[6], ow[7]};
        }
        u32x4 gc_[4], gp_[4], gw_, ga_;
        auto gloadA = [&](int hd_) {
            const int t = tid >> 3, c8 = (tid & 7) * 8, n = hd_ * 64 + c8; const unsigned row = m0 + t; const bool hasprev = (row & 4095u) != 0;
            const bf16_t* pr = P.p + (size_t)row * NP + CB0 + n;
#pragma unroll
            for (int qn = 0; qn < 4; ++qn) { gc_[qn] = *(const u32x4*)(pr + 512 * qn); gp_[qn] = (u32x4){0u, 0u, 0u, 0u}; if (hasprev) gp_[qn] = *(const u32x4*)(pr + 512 * qn - NP); }
            gw_ = *(const u32x4*)(P.wupT + (size_t)(hd_ * 64 + t) * 64 + c8); ga_ = *(const u32x4*)(P.aupT + (size_t)(hd_ * 64 + t) * 64 + c8);
        };
        gloadA(0);
        LBAR();
#pragma unroll 1
        for (int hd = 0; hd < 8; ++hd) {
            int tidl = tid; asm volatile("" : "+v"(tidl));
            const int lanel = tidl & 63; c.l16 = lanel & 15; c.quad = lanel >> 4;
            const int ci = ((grp >> 6) * 8 + hd) * 64 + (grp & 63);
            const size_t cb = (size_t)ci * 4096;
            float w0n[2], a0n[2], kkn[2], kan[2], rkn[2];
#pragma unroll
            for (int e = 0; e < 2; ++e) { const int n = hd * 64 + 16 * (c.nt0 + e) + c.l16; w0n[e] = P.w0[n]; a0n[e] = P.a0[n]; kkn[e] = P.k_k[n]; kan[e] = P.k_a[n]; rkn[e] = P.r_k[n]; }
            {
                const int t = tidl >> 3, c8 = (tidl & 7) * 8, n = hd * 64 + c8; const unsigned row = m0 + t;
                float xr[8], xk[8], xv[8], xg[8];
#define XS8(dst, CBQ, cu, pv) do { const f32x4 mA = *(const f32x4*)(MU + (CBQ) + n), mB = *(const f32x4*)(MU + (CBQ) + n + 4); \
                    const unsigned cw_[4] = {cu.x, cu.y, cu.z, cu.w}, pw_[4] = {pv.x, pv.y, pv.z, pv.w}; \
                    _Pragma("unroll") for (int j_ = 0; j_ < 4; ++j_) { const float l_ = bflo(cw_[j_]), h_ = bfhi(cw_[j_]); const float ml_ = j_ < 2 ? mA[2 * j_] : mB[2 * j_ - 4], mh_ = j_ < 2 ? mA[2 * j_ + 1] : mB[2 * j_ - 3]; \
                        dst[2 * j_] = l_ + ml_ * (bflo(pw_[j_]) - l_); dst[2 * j_ + 1] = h_ + mh_ * (bfhi(pw_[j_]) - h_); } } while (0)
                XS8(xr, CB_R, gc_[0], gp_[0]); XS8(xk, CB_K, gc_[1], gp_[1]); XS8(xv, CB_V, gc_[2], gp_[2]); XS8(xg, CB_G, gc_[3], gp_[3]);
#undef XS8
                *(u32x4*)(sRn + t * LQ + c8) = (u32x4){pk2(xr[0], xr[1]), pk2(xr[2], xr[3]), pk2(xr[4], xr[5]), pk2(xr[6], xr[7])};
                const f32x4 kA = *(const f32x4*)(P.k_k + n), kB = *(const f32x4*)(P.k_k + n + 4);
                float s = 0.f;
#pragma unroll
                for (int j = 0; j < 8; ++j) { XK[t * 65 + c8 + j] = xk[j]; const float kk = xk[j] * (j < 4 ? kA[j & 3] : kB[j & 3]); s += kk * kk; }
                s += dppf<0xB1>(s); s += dppf<0x4E>(s); s += dppf<0x141>(s);
                if ((tidl & 7) == 0) ssn[t] = rsqrtf(s + 1e-12f);
                const size_t fo = cb + (size_t)((((t >> 4) * 64 + ((c8 >> 2) & 3) * 16 + (t & 15)) * 4 + (c8 >> 4)) * 4);
                *(u32x2*)(P.sv + fo) = (u32x2){pk2(xv[0], xv[1]), pk2(xv[2], xv[3])}; *(u32x2*)(P.sv + fo + 256) = (u32x2){pk2(xv[4], xv[5]), pk2(xv[6], xv[7])};
#pragma unroll
                for (int j = 0; j < 8; ++j) { sVt[(c8 + j) * LQ + t] = f2bf(xv[j]); xg[j] = silu(xg[j]); }
                *(u32x2*)(P.sg + fo) = (u32x2){pk2(xg[0], xg[1]), pk2(xg[2], xg[3])}; *(u32x2*)(P.sg + fo + 256) = (u32x2){pk2(xg[4], xg[5]), pk2(xg[6], xg[7])};
                __builtin_amdgcn_sched_barrier(0);
                *(u32x4*)(WU + t * LQ + c8) = gw_; *(u32x4*)(AU + t * LQ + c8) = ga_;
                __builtin_amdgcn_sched_barrier(0);
                if (hd + 1 < 8) gloadA(hd + 1);
            }
            LBAR();
            f32x4 aw[2] = {z, z}, aa[2] = {z, z};
            MM2(aw, Awd, LQ, WU, LQ); MM2(aa, Aad, LQ, AU, LQ);
            f32x4 cum[2];
#pragma unroll
            for (int e = 0; e < 2; ++e) {
#pragma unroll
                for (int jj = 0; jj < 4; ++jj) aw[e][jj] = -0.60653066f * sigm(w0n[e] + aw[e][jj]);
                const float p0 = aw[e][0], p1 = p0 + aw[e][1], p2 = p1 + aw[e][2], p3 = p2 + aw[e][3];
                float x = p3;
                { const float y = __shfl_up(x, 16); if (c.quad >= 1) x += y; }
                { const float y = __shfl_up(x, 32); if (c.quad >= 2) x += y; }
                const float ex = x - p3;
                if (c.quad == 3) SEG[c.mt * 64 + 16 * (c.nt0 + e) + c.l16] = x;
                cum[e] = (f32x4){ex + p0, ex + p1, ex + p2, ex + p3};
            }
            LBAR();
#pragma unroll
            for (int e = 0; e < 2; ++e) {
                const int n = 16 * (c.nt0 + e) + c.l16;
                const float t0 = SEG[n], t1 = SEG[64 + n], t2 = SEG[128 + n], t3 = SEG[192 + n];
                const float off = (c.mt > 0 ? t0 : 0.f) + (c.mt > 1 ? t1 : 0.f) + (c.mt > 2 ? t2 : 0.f);
                cum[e] = cum[e] + off;
                if (c.mt == 0 && c.quad == 0) gCl[n] = __expf(t0 + t1 + t2 + t3);
            }
            {
                float bp[4] = {0.f, 0.f, 0.f, 0.f};
#pragma unroll
                for (int e = 0; e < 2; ++e) {
                    const int n = 16 * (c.nt0 + e) + c.l16;
                    float tA[4], tB[4], tK[4];
#pragma unroll
                    for (int jj = 0; jj < 4; ++jj) {
                        const int t = 16 * c.mt + 4 * c.quad + jj;
                        const float ec = cum[e][jj], lw = aw[e][jj], a = sigm(a0n[e] + aa[e][jj]), xk = XK[t * 65 + n], xr = bf2f(sRn[t * LQ + n]);
                        const float e1 = __expf(ec), gi = rcpf_(e1);
                        const float kk = xk * kkn[e] * ssn[t], kp = xk * (1.f + (a - 1.f) * kan[e]), bq = kk * a;
                        tA[jj] = -kk * __expf(ec - lw); tB[jj] = bq * gi; tK[jj] = kp * gi;
                        sAn[t * LQ + n] = f2bf(tA[jj]); sBn[t * LQ + n] = f2bf(tB[jj]); sKn[t * LQ + n] = f2bf(tK[jj]); sRn[t * LQ + n] = f2bf(xr * e1);
                        bp[jj] += xr * kp * rkn[e];
                    }
                    const int ot = n * LQ + 16 * c.mt + 4 * c.quad;
                    *(u32x2*)(sAt + ot) = (u32x2){pk2(tA[0], tA[1]), pk2(tA[2], tA[3])};
                    *(u32x2*)(sBt + ot) = (u32x2){pk2(tB[0], tB[1]), pk2(tB[2], tB[3])};
                    *(u32x2*)(sKt + ot) = (u32x2){pk2(tK[0], tK[1]), pk2(tK[2], tK[3])};
                }
#pragma unroll
                for (int jj = 0; jj < 4; ++jj) { const float s = reduce16(bp[jj]); if (c.l16 == 0) BP[(16 * c.mt + 4 * c.quad + jj) * 2 + (wv & 1)] = s; }
            }
            LBAR();
            if (tidl < 64) P.bonus[(size_t)(m0 + tidl) * 8 + hd] = BP[tidl * 2] + BP[tidl * 2 + 1];
            {
                f32x4 ab[2] = {z, z}, ak[2] = {z, z}, rb[2] = {z, z}, rk[2] = {z, z};
                const bool lv0 = c.mt <= c.nt0, lv1 = c.mt <= c.nt0 + 1;
                MM2P(ab, sBn, LQ, sAn, LQ, lv0, lv1); MM2P(ak, sKn, LQ, sAn, LQ, lv0, lv1); MM2P(rb, sBn, LQ, sRn, LQ, lv0, lv1); MM2P(rk, sKn, LQ, sRn, LQ, lv0, lv1);
#pragma unroll
                for (int e = 0; e < 2; ++e) {
                    const int t = 16 * (c.nt0 + e) + c.l16;
#pragma unroll
                    for (int jj = 0; jj < 4; ++jj) { const int s = 16 * c.mt + 4 * c.quad + jj;
                        if (!(s < t)) { ab[e][jj] = 0.f; ak[e][jj] = 0.f; }
                        if (!(s <= t)) { rb[e][jj] = 0.f; rk[e][jj] = 0.f; } }
                    storeT_bf(Ma, LQ, c, e, ab[e]); storeT_bf(Lak, LQ, c, e, ak[e]); storeT_bf(Lrb, LQ, c, e, rb[e]); storeT_bf(Lrk, LQ, c, e, rk[e]);
                }
            }
            LBAR();
            if (tidl < 224) {
                const int blk = tidl >> 5, rr = (tidl >> 1) & 15, hf = tidl & 1;
                const int br = blk == 6 ? 1 : (blk < 3 ? 0 : (blk < 5 ? 1 : 2)), bc = blk == 6 ? 0 : (blk < 3 ? blk + 1 : (blk < 5 ? blk - 1 : 3));
                bf16_t* zp = (blk == 6 ? TmT : Tm) + (16 * br + rr) * LQ + 16 * bc + 8 * hf;
                *(u32x4*)zp = (u32x4){0u, 0u, 0u, 0u};
            }
            if (wv == 0) {
                const int d = lanel >> 4, cc = lanel & 15; float tv[16];
#pragma unroll
                for (int rr = 0; rr < 16; ++rr) {
                    const bf16_t* nr = Ma + (16 * d + rr) * LQ + 16 * d; const u32x4 q0 = *(const u32x4*)nr, q1 = *(const u32x4*)(nr + 8);
                    const float nv[16] = {bflo(q0.x), bfhi(q0.x), bflo(q0.y), bfhi(q0.y), bflo(q0.z), bfhi(q0.z), bflo(q0.w), bfhi(q0.w), bflo(q1.x), bfhi(q1.x), bflo(q1.y), bfhi(q1.y), bflo(q1.z), bfhi(q1.z), bflo(q1.w), bfhi(q1.w)};
                    float a = (rr == cc) ? 1.f : 0.f;
#pragma unroll
                    for (int ss = 0; ss < rr; ++ss) a += nv[ss] * tv[ss];
                    tv[rr] = a;
                    Tm[(16 * d + rr) * LQ + 16 * d + cc] = f2bf(a);
                }
                bf16_t* tr = TmT + (16 * d + cc) * LQ + 16 * d;
                *(u32x4*)tr = (u32x4){pk2(tv[0], tv[1]), pk2(tv[2], tv[3]), pk2(tv[4], tv[5]), pk2(tv[6], tv[7])};
                *(u32x4*)(tr + 8) = (u32x4){pk2(tv[8], tv[9]), pk2(tv[10], tv[11]), pk2(tv[12], tv[13]), pk2(tv[14], tv[15])};
            }
            {
                f32x4 acc[2] = {z, z}; MM2(acc, Lak, LQ, sVt, LQ);
#pragma unroll
                for (int e = 0; e < 2; ++e) storeT_bf(W2T, LQ, c, e, acc[e]);
            }
            LBAR();
            if (wv < 2) {
                const int lo = 32 * wv, hi = lo + 16;
                const f32x4 a = mm1<16>(z, Ma, hi, TmT, lo, lo, c.l16, c.quad); st1T(Zt, hi, lo, c.l16, c.quad, a);
                const f32x4 b = mm1<16>(z, Tm, hi, Zt, lo, hi, c.l16, c.quad); st1N(Tm, hi, lo, c.l16, c.quad, b); st1T(TmT, hi, lo, c.l16, c.quad, b);
            }
            LBAR();
            if (wv < 2) {
                const int ub = 16 * wv;
                const f32x4 a0 = mm1<32>(z, Ma, 32, TmT, ub, 0, c.l16, c.quad), a1 = mm1<32>(z, Ma, 48, TmT, ub, 0, c.l16, c.quad);
                st1T(Zt, 32, ub, c.l16, c.quad, a0); st1T(Zt, 48, ub, c.l16, c.quad, a1);
                const f32x4 b0 = mm1<32>(z, Zt, ub, Tm, 32, 32, c.l16, c.quad), b1 = mm1<32>(z, Zt, ub, Tm, 48, 32, c.l16, c.quad);
                st1T(Tm, ub, 32, c.l16, c.quad, b0); st1T(Tm, ub, 48, c.l16, c.quad, b1);
            }
            LBAR();
            {
                f32x4 ap[2] = {z, z}, aq[2] = {z, z};
                MM2(ap, Tm, LQ, sAt, LQ); MM2(aq, Tm, LQ, W2T, LQ);
#pragma unroll
                for (int e = 0; e < 2; ++e) { storeT_bf(PT, LQ, c, e, ap[e]); storeT_bf(QT, LQ, c, e, aq[e]); }
            }
            LBAR();
            {
                f32x4 ar[2] = {z, z}, ag[2] = {z, z};
                MM2(ar, PT, LQ, Lrb, LQ);
                MM2(ag, PT, LQ, sBt, LQ);
#pragma unroll
                for (int e = 0; e < 2; ++e) {
                    const int n = 16 * (c.nt0 + e) + c.l16, mm0 = 16 * c.mt + 4 * c.quad; const size_t o = cb + (size_t)n * 64 + mm0;
                    const f32x4 rr = loadT_bf(sRn, LQ, c, e) + ar[e];
                    *(u32x2*)(P.cR + cb + (size_t)(((((c.nt0 + e) * 2 + (c.mt >> 1)) * 64 + c.quad * 16 + c.l16) * 2 + (c.mt & 1)) * 4)) = (u32x2){pk2(rr[0], rr[1]), pk2(rr[2], rr[3])};
                    const float gc = gCl[n];
                    f32x4 gg = ag[e];
#pragma unroll
                    for (int jj = 0; jj < 4; ++jj) gg[jj] = gc * (gg[jj] + (mm0 + jj == n ? 1.f : 0.f));
                    *(u32x2*)(P.cG + cb + (size_t)(((((c.nt0 + e) * 2 + (c.mt >> 1)) * 64 + c.quad * 16 + c.l16) * 2 + (c.mt & 1)) * 4)) = (u32x2){pk2(gg[0], gg[1]), pk2(gg[2], gg[3])};
                }
            }
            __builtin_amdgcn_sched_barrier(0);
            {
                f32x4 ay[2] = {z, z}, ah[2] = {z, z};
                MM2(ay, QT, LQ, Lrb, LQ); MM2(ay, sVt, LQ, Lrk, LQ);
                MM2(ah, sBt, LQ, QT, LQ); MM2(ah, sKt, LQ, sVt, LQ);
#pragma unroll
                for (int e = 0; e < 2; ++e) {
                    const int n = 16 * (c.nt0 + e) + c.l16, mm0 = 16 * c.mt + 4 * c.quad; const size_t o = cb + (size_t)n * 64 + mm0;
                    const size_t of = cb + (size_t)((((c.nt0 + e) * 64 + c.quad * 16 + c.l16) * 4 + c.mt) * 4);
                    *(u32x2*)(P.cY + of) = (u32x2){pk2(ay[e][0], ay[e][1]), pk2(ay[e][2], ay[e][3])};
                    const f32x4 hh = ah[e] * *(const f32x4*)(gCl + mm0);
                    *(u32x2*)(P.cH + of) = (u32x2){pk2(hh[0], hh[1]), pk2(hh[2], hh[3])};
                }
            }
            LBAR();
        }
    }
}

__device__ void phase4b(const Params& P) {
    const int tid = threadIdx.x, wv = tid >> 6, lane = tid & 63, l16 = lane & 15, quad = lane >> 4;
    for (int item = wv * (int)gridDim.x + (int)blockIdx.x; item < 256; item += 8 * (int)gridDim.x) {
        const int bh = item >> 2, ig = item & 3, b = bh >> 3, hd = bh & 7;
        f32x4 S[4];
#pragma unroll
        for (int mt = 0; mt < 4; ++mt) S[mt] = (f32x4){0.f, 0.f, 0.f, 0.f};
        u32x2 gG[4][2][2], gR[4][2][2]; f32x4 gH[4], gY[4];
        auto gload = [&](int cidx) {
            const size_t cb = ((size_t)bh * 64 + cidx) * 4096;
#pragma unroll
            for (int mt = 0; mt < 4; ++mt) {
#pragma unroll
                for (int ks = 0; ks < 2; ++ks)
#pragma unroll
                    for (int hf = 0; hf < 2; ++hf) {
                        gG[mt][ks][hf] = *(const u32x2*)(P.cG + cb + (size_t)(16 * mt + l16) * 64 + 32 * ks + 16 * hf + 4 * quad);
                        gR[mt][ks][hf] = *(const u32x2*)(P.cR + cb + (size_t)(16 * mt + l16) * 64 + 32 * ks + 16 * hf + 4 * quad);
                    }
                gH[mt] = *(const f32x4*)(P.cH + cb + (size_t)(16 * ig + l16) * 64 + 16 * mt + 4 * quad);
                gY[mt] = *(const f32x4*)(P.cY + cb + (size_t)(16 * ig + l16) * 64 + 16 * mt + 4 * quad);
            }
        };
        gload(0);
        for (int cidx = 0; cidx < 64; ++cidx) {
            bf16x8 bhi[2], blo[2];
#pragma unroll
            for (int ks = 0; ks < 2; ++ks) {
                u32x4 wh, wl;
#pragma unroll
                for (int hf = 0; hf < 2; ++hf) {
                    const f32x4 v = S[2 * ks + hf];
                    const unsigned h0 = pk2(v[0], v[1]), h1 = pk2(v[2], v[3]);
                    const unsigned l0 = pk2(v[0] - bflo(h0), v[1] - bfhi(h0)), l1 = pk2(v[2] - bflo(h1), v[3] - bfhi(h1));
                    if (hf == 0) { wh.x = h0; wh.y = h1; wl.x = l0; wl.y = l1; } else { wh.z = h0; wh.w = h1; wl.z = l0; wl.w = l1; }
                }
                bhi[ks] = __builtin_bit_cast(bf16x8, wh); blo[ks] = __builtin_bit_cast(bf16x8, wl);
            }
            f32x4 Y[4], Sn[4];
#pragma unroll
            for (int mt = 0; mt < 4; ++mt) {
                Y[mt] = gY[mt]; Sn[mt] = gH[mt];
#pragma unroll
                for (int ks = 0; ks < 2; ++ks) {
                    const bf16x8 ar = __builtin_bit_cast(bf16x8, (u32x4){gR[mt][ks][0].x, gR[mt][ks][0].y, gR[mt][ks][1].x, gR[mt][ks][1].y});
                    const bf16x8 ag = __builtin_bit_cast(bf16x8, (u32x4){gG[mt][ks][0].x, gG[mt][ks][0].y, gG[mt][ks][1].x, gG[mt][ks][1].y});
                    Y[mt] = mfma16(ar, bhi[ks], Y[mt]); Y[mt] = mfma16(ar, blo[ks], Y[mt]);
                    Sn[mt] = mfma16(ag, bhi[ks], Sn[mt]); Sn[mt] = mfma16(ag, blo[ks], Sn[mt]);
                }
            }
            if (cidx + 1 < 64) gload(cidx + 1);
            const size_t rowb = (size_t)b * T + (size_t)cidx * 64;
#pragma unroll
            for (int mt = 0; mt < 4; ++mt) {
#pragma unroll
                for (int jj = 0; jj < 4; ++jj) P.y[(rowb + 16 * mt + 4 * quad + jj) * 512 + hd * 64 + 16 * ig + l16] = Y[mt][jj];
                S[mt] = Sn[mt];
            }
        }
    }
}

__device__ void phase5(const Params& P) {
    const int tid = threadIdx.x, tl = tid >> 7, hd = (tid >> 4) & 7, l16 = tid & 15, n = hd * 64 + l16 * 4;
    for (int it = blockIdx.x; it < MTOK / 4; it += gridDim.x) {
        const size_t row = (size_t)it * 4 + tl, o = row * 512 + n;
        const f32x4 yv = *(const f32x4*)(P.y + o);
        float s = yv[0] + yv[1] + yv[2] + yv[3]; s = reduce16(s);
        const float mean = s * (1.f / 64.f);
        const f32x4 dv = yv - mean;
        float q = dv[0] * dv[0] + dv[1] * dv[1] + dv[2] * dv[2] + dv[3] * dv[3]; q = reduce16(q);
        const float rstd = rsqrtf(q * (1.f / 64.f) + GN_EPS);
        const u32x2 vv = *(const u32x2*)(P.sv + o), gg = *(const u32x2*)(P.sg + o);
        const float v4[4] = {bflo(vv.x), bfhi(vv.x), bflo(vv.y), bfhi(vv.y)}, g4[4] = {bflo(gg.x), bfhi(gg.x), bflo(gg.y), bfhi(gg.y)};
        const float bs = P.bonus[row * 8 + hd];
        float ov[4];
#pragma unroll
        for (int j = 0; j < 4; ++j) ov[j] = (dv[j] * rstd * P.gn_g[n + j] + P.gn_b[n + j] + bs * v4[j]) * g4[j];
        *(u32x2*)(P.hbf + row * D + 512 + n) = (u32x2){pk2(ov[0], ov[1]), pk2(ov[2], ov[3])};
    }
}


__device__ void phase4s(const Params& P) {
    const int tid = threadIdx.x, wv = tid >> 6, lane = tid & 63, l16 = lane & 15, quad = lane >> 4;
    for (int item = wv * (int)gridDim.x + (int)blockIdx.x; item < 256; item += 8 * (int)gridDim.x) {
        const int bh = item >> 2, ig = item & 3;
        f32x4 S[4];
#pragma unroll
        for (int mt = 0; mt < 4; ++mt) S[mt] = (f32x4){0.f, 0.f, 0.f, 0.f};
        u32x4 gG[4][8]; u32x2 gH[4][4];
#define G4LOAD(u, cidx) do { const size_t cb_ = ((size_t)bh * 64 + (cidx)) * 4096; \
            _Pragma("unroll") for (int f_ = 0; f_ < 8; ++f_) gG[u][f_] = *(const u32x4*)(P.cG + cb_ + (size_t)(f_ * 64 + lane) * 8); \
            { const u32x4 h0_ = *(const u32x4*)(P.cH + cb_ + (size_t)(ig * 64 + lane) * 16), h1_ = *(const u32x4*)(P.cH + cb_ + (size_t)(ig * 64 + lane) * 16 + 8); \
              gH[u][0] = (u32x2){h0_.x, h0_.y}; gH[u][1] = (u32x2){h0_.z, h0_.w}; gH[u][2] = (u32x2){h1_.x, h1_.y}; gH[u][3] = (u32x2){h1_.z, h1_.w}; } } while (0)
        G4LOAD(0, 0); G4LOAD(1, 1); G4LOAD(2, 2);
#pragma unroll 1
        for (int c0 = 0; c0 < 64; c0 += 4) {
#pragma unroll
            for (int u = 0; u < 4; ++u) {
                const int cidx = c0 + u;
                { const int nc = cidx + 3 < 64 ? cidx + 3 : 63; G4LOAD((u + 3) & 3, nc); }
                __builtin_amdgcn_sched_barrier(0);
                const size_t cb = ((size_t)bh * 64 + cidx) * 4096;
                bf16x8 bhi[2], blo[2];
#pragma unroll
                for (int ks = 0; ks < 2; ++ks) {
                    u32x4 wh, wl;
#pragma unroll
                    for (int hf = 0; hf < 2; ++hf) {
                        const f32x4 v = S[2 * ks + hf];
                        const unsigned h0 = pk2(v[0], v[1]), h1 = pk2(v[2], v[3]);
                        const unsigned l0 = pk2(v[0] - bflo(h0), v[1] - bfhi(h0)), l1 = pk2(v[2] - bflo(h1), v[3] - bfhi(h1));
                        if (hf == 0) { wh.x = h0; wh.y = h1; wl.x = l0; wl.y = l1; } else { wh.z = h0; wh.w = h1; wl.z = l0; wl.w = l1; }
                    }
                    bhi[ks] = __builtin_bit_cast(bf16x8, wh); blo[ks] = __builtin_bit_cast(bf16x8, wl);
                    *(u32x4*)(P.cS + cb + (size_t)((ig * 2 + ks) * 64 + lane) * 8) = wh;
                }
#pragma unroll
                for (int mt = 0; mt < 4; ++mt) {
                    f32x4 sn = {bflo(gH[u][mt].x), bfhi(gH[u][mt].x), bflo(gH[u][mt].y), bfhi(gH[u][mt].y)};
#pragma unroll
                    for (int ks = 0; ks < 2; ++ks) { const bf16x8 ag = __builtin_bit_cast(bf16x8, gG[u][mt * 2 + ks]); sn = mfma16(ag, bhi[ks], sn); sn = mfma16(ag, blo[ks], sn); }
                    S[mt] = sn;
                }
            }
        }
#undef G4LOAD
    }
}

__device__ void phase5y(const Params& P) {
    const int tid = threadIdx.x, wv = tid >> 6, lane = tid & 63, l16 = lane & 15, quad = lane >> 4;
    for (int ci = (int)blockIdx.x * 8 + wv; ci < 4096; ci += 8 * (int)gridDim.x) {
        const size_t cb = (size_t)ci * 4096;
        const int bh = ci >> 6, cidx = ci & 63, b = bh >> 3, hd = bh & 7;
        bf16x8 as[4][2];
#pragma unroll
        for (int mt = 0; mt < 4; ++mt)
#pragma unroll
            for (int ks = 0; ks < 2; ++ks) as[mt][ks] = *(const bf16x8*)(P.cS + cb + (size_t)((mt * 2 + ks) * 64 + lane) * 8);
#pragma unroll 1
        for (int half = 0; half < 2; ++half) {
            f32x4 acc[2][4]; bf16x8 br[2][2]; u32x2 vv[2][4], gg[2][4]; float bs[2]; size_t rowv[2];
#pragma unroll
            for (int u = 0; u < 2; ++u) {
                const int t = 16 * (2 * half + u) + l16;
                rowv[u] = (size_t)b * T + (size_t)cidx * 64 + t;
#pragma unroll
                for (int mt = 0; mt < 4; ++mt) {
                    { const u32x2 yq = *(const u32x2*)(P.cY + cb + (size_t)(((2 * half + u) * 64 + lane) * 4 + mt) * 4); acc[u][mt] = (f32x4){bflo(yq.x), bfhi(yq.x), bflo(yq.y), bfhi(yq.y)}; }
                    const int n = hd * 64 + 16 * mt + 4 * quad;
                    vv[u][mt] = *(const u32x2*)(P.sv + cb + (size_t)(((2 * half + u) * 64 + lane) * 4 + mt) * 4); gg[u][mt] = *(const u32x2*)(P.sg + cb + (size_t)(((2 * half + u) * 64 + lane) * 4 + mt) * 4);
                }
#pragma unroll
                for (int ks = 0; ks < 2; ++ks) br[u][ks] = *(const bf16x8*)(P.cR + cb + (size_t)(((2 * half + u) * 2 + ks) * 64 + lane) * 8);
                bs[u] = P.bonus[rowv[u] * 8 + hd];
            }
#pragma unroll
            for (int u = 0; u < 2; ++u) {
#pragma unroll
                for (int ks = 0; ks < 2; ++ks)
#pragma unroll
                    for (int mt = 0; mt < 4; ++mt) acc[u][mt] = mfma16(as[mt][ks], br[u][ks], acc[u][mt]);
                float s = 0.f;
#pragma unroll
                for (int mt = 0; mt < 4; ++mt) s += acc[u][mt][0] + acc[u][mt][1] + acc[u][mt][2] + acc[u][mt][3];
                s += __shfl_xor(s, 16); s += __shfl_xor(s, 32);
                const float mean = s * (1.f / 64.f);
                float q = 0.f;
#pragma unroll
                for (int mt = 0; mt < 4; ++mt) { acc[u][mt] = acc[u][mt] - mean; q += acc[u][mt][0] * acc[u][mt][0] + acc[u][mt][1] * acc[u][mt][1] + acc[u][mt][2] * acc[u][mt][2] + acc[u][mt][3] * acc[u][mt][3]; }
                q += __shfl_xor(q, 16); q += __shfl_xor(q, 32);
                const float rstd = rsqrtf(q * (1.f / 64.f) + GN_EPS);
#pragma unroll
                for (int mt = 0; mt < 4; ++mt) {
                    const int n = hd * 64 + 16 * mt + 4 * quad;
                    const f32x4 g = *(const f32x4*)(P.gn_g + n), be = *(const f32x4*)(P.gn_b + n);
                    const f32x4 v4 = {bflo(vv[u][mt].x), bfhi(vv[u][mt].x), bflo(vv[u][mt].y), bfhi(vv[u][mt].y)}, g4 = {bflo(gg[u][mt].x), bfhi(gg[u][mt].x), bflo(gg[u][mt].y), bfhi(gg[u][mt].y)};
                    const f32x4 o = (acc[u][mt] * rstd * g + be + bs[u] * v4) * g4;
                    *(u32x2*)(P.hbf + rowv[u] * D + 512 + n) = (u32x2){pk2(o[0], o[1]), pk2(o[2], o[3])};
                }
            }
        }
    }
}

struct EpiOut {
    static constexpr bool PERM = true, AFTER_DRAIN = false;
    bf16_t* C; const float* mod;
    __device__ __forceinline__ void operator()(const pg8::f32x4 (&acc)[2][2][4][2], const pg8::Unit& u, int wr, int wc, int fr, int fq) const {
        const int row0 = u.pm * 256 + wr * 64 + fr, col0 = u.pn * 256 + wc * 32 + 8 * fq, b = (u.pm * 256) >> 12;
        pg8::f32x4 gv[2][2];
#pragma unroll
        for (int bj = 0; bj < 2; ++bj)
#pragma unroll
            for (int n = 0; n < 2; ++n) gv[bj][n] = *(const pg8::f32x4*)(mod + b * 3072 + 2048 + col0 + bj * 128 + 4 * n);
#pragma unroll
        for (int ai = 0; ai < 2; ++ai)
#pragma unroll
            for (int m = 0; m < 4; ++m) { const size_t ro = (size_t)(row0 + ai * 128 + m * 16) * 1024 + col0;
#pragma unroll
                for (int bj = 0; bj < 2; ++bj) {
                    const pg8::f32x4 v0 = gv[bj][0] * acc[ai][bj][m][0], v1 = gv[bj][1] * acc[ai][bj][m][1];
                    *(u32x4*)(C + ro + bj * 128) = (u32x4){pk2(v0[0], v0[1]), pk2(v0[2], v0[3]), pk2(v1[0], v1[1]), pk2(v1[2], v1[3])}; } }
    }
};

__device__ void phase7(const Params& P) {
    const int wv = threadIdx.x >> 6, lane = threadIdx.x & 63;
    f32x4 g4[4], b4[4];
#pragma unroll
    for (int q = 0; q < 4; ++q) { g4[q] = *(const f32x4*)(P.ln_g + (q >> 1) * 512 + lane * 8 + (q & 1) * 4); b4[q] = *(const f32x4*)(P.ln_b + (q >> 1) * 512 + lane * 8 + (q & 1) * 4); }
    for (int it = blockIdx.x; it < MTOK / 8; it += gridDim.x) {
        const size_t row = (size_t)it * 8 + wv;
        const bf16_t* sp = P.pre + row * D + lane * 8;
        const u32x4 w0 = *(const u32x4*)sp, w1 = *(const u32x4*)(sp + 512);
        f32x4 v[4] = {{bflo(w0.x), bfhi(w0.x), bflo(w0.y), bfhi(w0.y)}, {bflo(w0.z), bfhi(w0.z), bflo(w0.w), bfhi(w0.w)}, {bflo(w1.x), bfhi(w1.x), bflo(w1.y), bfhi(w1.y)}, {bflo(w1.z), bfhi(w1.z), bflo(w1.w), bfhi(w1.w)}};
        { const float* xp = P.x + row * D + lane * 8;
#pragma unroll
          for (int q = 0; q < 4; ++q) v[q] = v[q] + ALPHA * *(const f32x4*)(xp + (q >> 1) * 512 + (q & 1) * 4); }
        float s = 0.f;
#pragma unroll
        for (int q = 0; q < 4; ++q) s += v[q][0] + v[q][1] + v[q][2] + v[q][3];
#pragma unroll
        for (int o = 32; o > 0; o >>= 1) s += __shfl_xor(s, o);
        const float mean = s * (1.f / 1024.f);
        float qq = 0.f;
#pragma unroll
        for (int q = 0; q < 4; ++q) { v[q] = v[q] - mean; qq += v[q][0] * v[q][0] + v[q][1] * v[q][1] + v[q][2] * v[q][2] + v[q][3] * v[q][3]; }
#pragma unroll
        for (int o = 32; o > 0; o >>= 1) qq += __shfl_xor(qq, o);
        const float rstd = rsqrtf(qq * (1.f / 1024.f) + LN_EPS);
        float* rp = P.out + row * D + lane * 8;
#pragma unroll
        for (int q = 0; q < 4; ++q) *(f32x4*)(rp + (q >> 1) * 512 + (q & 1) * 4) = v[q] * rstd * g4[q] + b4[q];
    }
}

#define XB_TMO      128
#define XB_XCNT(j)  (256  + 64 * (j))
#define XB_XSUB(j)  (1280 + 64 * (j))
#define XB_XGEN(j)  (2304 + 64 * (j))
#define XB_TOP      3328
#define XB_TOPGEN   3392
#define XCD_BAR_WORDS 3456
#define XB_SPIN_CAP (1u << 18)
#define LAS __attribute__((address_space(3)))

__device__ __forceinline__ unsigned xb_ld(unsigned* p)              { return __hip_atomic_load(p, __ATOMIC_RELAXED, __HIP_MEMORY_SCOPE_AGENT); }
__device__ __forceinline__ unsigned xb_add(unsigned* p, unsigned v) { return __hip_atomic_fetch_add(p, v, __ATOMIC_RELAXED, __HIP_MEMORY_SCOPE_AGENT); }
__device__ __forceinline__ unsigned xb_xcc_id() { return (unsigned)__builtin_amdgcn_s_getreg((3 << 11) | 20) & 0xFu; }
#define XB_SPIN(cond, bar) do { unsigned _sp = 0; while (cond) { __builtin_amdgcn_s_sleep(1); \
    if ((++_sp & 255u) == 0u) { if (xb_ld(&(bar)[XB_TMO])) break; if (_sp > XB_SPIN_CAP) { atomicAdd(&(bar)[XB_TMO], 1u); break; } } } } while (0)

struct XcdBarrier {
    unsigned* bar; unsigned x;
    volatile LAS unsigned* st;
};

__device__ __forceinline__ XcdBarrier xcd_barrier_post(unsigned* bar, volatile LAS unsigned* st) {
    XcdBarrier b; b.bar = bar; b.x = xb_xcc_id(); b.st = st;
    if (threadIdx.x == 0) (void)xb_add(&bar[XB_XCNT(b.x)], 1u);
    return b;
}
__device__ __forceinline__ void xcd_barrier_complete(unsigned* bar, unsigned x, unsigned& nloc, unsigned& nx) {
    const unsigned G = gridDim.x * gridDim.y * gridDim.z;
    unsigned sum, cnt, mine, sp = 0u;
    for (;;) {
        sum = 0u; cnt = 0u; mine = 0u;
#pragma unroll
        for (unsigned j = 0; j < 16; ++j) { const unsigned c = xb_ld(&bar[XB_XCNT(j)]); sum += c; cnt += (c > 0u) ? 1u : 0u; mine = (j == x) ? c : mine; }
        if (sum == G) break;
        __builtin_amdgcn_s_sleep(1);
        if ((++sp & 255u) == 0u) { if (xb_ld(&bar[XB_TMO])) break; if (sp > XB_SPIN_CAP) { atomicAdd(&bar[XB_TMO], 1u); break; } }
    }
    nloc = mine > 0u ? mine : 1u; nx = cnt > 0u ? cnt : 1u;
}

__device__ __forceinline__ void xcd_barrier(const XcdBarrier& b) {
    asm volatile("s_waitcnt vmcnt(0)" ::: "memory");
    __syncthreads();
    if (threadIdx.x == 0) {
        unsigned* bar = b.bar;
        __builtin_amdgcn_s_waitcnt(0);
        unsigned nloc = b.st[0], nx = b.st[1];
        if (nloc == 0u) { xcd_barrier_complete(bar, b.x, nloc, nx); b.st[0] = nloc; b.st[1] = nx; }
        const unsigned old = xb_add(&bar[XB_XSUB(b.x)], 1u);
        const unsigned gen = old / nloc;
        if (old + 1u == (gen + 1u) * nloc) {
            __builtin_amdgcn_fence(__ATOMIC_RELEASE, "agent");
            asm volatile("s_waitcnt vmcnt(0)" ::: "memory");
            const unsigned og = xb_add(&bar[XB_TOP], 1u);
            const unsigned tg = og / nx;
            if (og + 1u == (tg + 1u) * nx) xb_add(&bar[XB_TOPGEN], 1u);
            else XB_SPIN(xb_ld(&bar[XB_TOPGEN]) == tg, bar);
            __builtin_amdgcn_fence(__ATOMIC_ACQUIRE, "agent");
            xb_add(&bar[XB_XGEN(b.x)], 1u);
            asm volatile("s_waitcnt vmcnt(0)" ::: "memory");
        } else {
            XB_SPIN(xb_ld(&bar[XB_XGEN(b.x)]) == gen, bar);
            __builtin_amdgcn_fence(__ATOMIC_ACQUIRE, "agent");
            asm volatile("s_waitcnt vmcnt(0)" ::: "memory");
        }
    }
    __syncthreads();
}


constexpr int NPHASE = 8;
#ifndef PHM
#define PHM 511
#endif
#ifndef DBL
#define DBL 0
#endif
#define REP(bit) for (int _rep = 0; _rep < (((DBL) >> (bit)) & 1) + 1; ++_rep)
__global__ void __launch_bounds__(512, 2) mega(Params Pin) {
    extern __shared__ __attribute__((aligned(16))) unsigned char lds[];
    cg::grid_group grid = cg::this_grid();
    volatile LAS unsigned* xst = (volatile LAS unsigned*)(lds + XB_LDS_OFF);
    if (threadIdx.x < 4) xst[threadIdx.x] = 0u;
    __syncthreads();
    typedef const __attribute__((address_space(4))) Params* KP;
    const KP kp = (KP)__builtin_amdgcn_kernarg_segment_ptr();
    const int ph_lo = kp->phase_lo, ph_hi = kp->phase_hi;
    if (ph_lo < 0) grid.sync();
    const XcdBarrier xb = xcd_barrier_post(kp->xbar, xst);
#if defined(__HIP_DEVICE_COMPILE__)
#define LOADP() KP q = kp; asm volatile("" : "+s"(q)); const Params P = *q
#else
#define LOADP() const Params P = Pin
#endif
#define RUNS(ph) (ph_lo <= (ph) && (ph) < ph_hi)
#define SYNC_AFTER(ph) if (ph_lo <= (ph) && (ph) + 1 < ph_hi) xcd_barrier(xb)
    if (RUNS(0)) { LOADP(); if (PHM & 1) REP(5) { phase0(P, lds); __syncthreads(); } }
    SYNC_AFTER(0);
    if (RUNS(1)) { LOADP(); if (PHM & 2) REP(6) phase1(P); }
    SYNC_AFTER(1);
    if (RUNS(2)) { LOADP(); if (PHM & 4) REP(7) {
        pg8::Gemm g{P.hbf, P.wt_in, MTOK, NP, D}; pg8::StaticOrder S; S.init(MTOK, NP, (int)gridDim.x, (int)blockIdx.x, WGM_MAIN);
        pg8::EpiBf16<0> E{P.p, NP, nullptr, 0, 0};
        pg8::gemm_phase<pg8::EpiBf16<0>, pg8::StaticOrder, false>((PG8_LAS unsigned char*)lds, g, S, E, nullptr); } }
    SYNC_AFTER(2);
    if (RUNS(3)) { { LOADP(); if (PHM & 8) REP(0) phase3a(P, lds); } __syncthreads(); { LOADP(); if (PHM & 256) REP(1) { phaseF(P, lds); __syncthreads(); } } }
    SYNC_AFTER(3);
    if (RUNS(4)) { LOADP(); if (PHM & 16) REP(3) phase4s(P); }
    SYNC_AFTER(4);
    if (RUNS(5)) { LOADP(); if (PHM & 32) REP(4) phase5y(P); }
    SYNC_AFTER(5);
    if (RUNS(6)) { LOADP(); if (PHM & 64) REP(8) {
        pg8::Gemm g{P.hbf, P.wt_out, MTOK, D, D}; pg8::StaticOrder S; S.init(MTOK, D, (int)gridDim.x, (int)blockIdx.x, WGM_OUT);
        EpiOut E{P.pre, P.mod};
        pg8::gemm_phase<EpiOut, pg8::StaticOrder, false>((PG8_LAS unsigned char*)lds, g, S, E, nullptr); } }
    SYNC_AFTER(6);
    if (RUNS(7)) { LOADP(); if (PHM & 128) phase7(P); }
}

#ifndef MULTI_LAUNCH
#define MULTI_LAUNCH 0
#endif
extern "C" void kernel_launch(void* const* d_in, const int* in_sizes, int n_in, void* d_out, int out_size, void* d_ws, size_t ws_size, hipStream_t stream) {
    static int grid = 0;
    if (grid == 0) {
        int dev = 0, cus = 0, per_cu = 0;
        hipGetDevice(&dev); hipDeviceGetAttribute(&cus, hipDeviceAttributeMultiprocessorCount, dev);
        if (hipFuncSetAttribute((const void*)mega, hipFuncAttributeMaxDynamicSharedMemorySize, LDS_BYTES) != hipSuccess) fprintf(stderr, "kernel_launch: hipFuncSetAttribute failed\n");
        if (hipOccupancyMaxActiveBlocksPerMultiprocessor(&per_cu, (const void*)mega, 512, LDS_BYTES) != hipSuccess || per_cu < 1) { fprintf(stderr, "kernel_launch: occupancy query gave %d\n", per_cu); per_cu = 1; }
        (void)hipGetLastError();
        grid = cus * per_cu;
        fprintf(stderr, "kernel_launch: grid %d (%d CUs x %d)\n", grid, cus, per_cu);
    }
    Params P{};
    const float** pin = (const float**)&P.x;
    for (int i = 0; i < 22; ++i) pin[i] = (const float*)d_in[i];
    P.out = (float*)d_out;
    unsigned char* w = (unsigned char*)d_ws; size_t off = 0;
    auto take = [&](size_t bytes) { unsigned char* q = w + off; off += (bytes + 255) & ~(size_t)255; return q; };
    P.mod = (float*)take(8 * 3072 * 4);
    P.hbf = (bf16_t*)take((size_t)MTOK * D * 2);
    P.wt_in = (bf16_t*)take((size_t)NP * D * 2);
    P.wt_out = (bf16_t*)take((size_t)D * D * 2);
    P.wupT = (bf16_t*)take(512 * 64 * 2);
    P.aupT = (bf16_t*)take(512 * 64 * 2);
    P.p = (bf16_t*)take((size_t)MTOK * NP * 2);
    P.xbar = (unsigned*)take(XCD_BAR_WORDS * 4);
    P.gC = (float*)take((size_t)4096 * 64 * 4); P.bonus = (float*)take((size_t)MTOK * 8 * 4);
    const size_t AB = (size_t)MTOK * 512 * 2;
    P.sv = (bf16_t*)take(AB); P.sg = (bf16_t*)take(AB); P.An = (bf16_t*)take(AB); P.Bn = (bf16_t*)take(AB); P.Kn = (bf16_t*)take(AB); P.Rn = (bf16_t*)take(AB);
    {
        unsigned char* q = (unsigned char*)d_out; P.At = (bf16_t*)q; P.Bt = (bf16_t*)(q + AB); P.Kt = (bf16_t*)(q + 2 * AB); P.Vt = (bf16_t*)(q + 3 * AB);
    }
    P.y = (float*)d_out;
    P.pre = P.p;
    P.cS = (bf16_t*)d_out;
    P.cG = P.An; P.cR = P.Bn; P.cH = P.Kn; P.cY = P.Rn;
    if (off > ws_size) { fprintf(stderr, "kernel_launch: workspace too small (%zu > %zu)\n", off, ws_size); return; }
    if (hipMemsetAsync(P.xbar, 0, XCD_BAR_WORDS * 4, stream) != hipSuccess) fprintf(stderr, "kernel_launch: memset of the barrier words failed\n");
#if MULTI_LAUNCH
    for (int ph = 0; ph < NPHASE; ++ph) { P.phase_lo = ph; P.phase_hi = ph + 1; hipLaunchKernelGGL(mega, dim3(grid), dim3(512), LDS_BYTES, stream, P); }
#else
    P.phase_lo = 0; P.phase_hi = NPHASE;
    void* args[] = {&P};
    hipError_t e = hipLaunchCooperativeKernel((const void*)mega, dim3(grid), dim3(512), args, LDS_BYTES, stream);
    if (e != hipSuccess) fprintf(stderr, "kernel_launch: cooperative launch failed: %s (grid %d)\n", hipGetErrorString(e), grid);
#endif
}
```

```cpp
#include <hip/hip_runtime.h>
#include <hip/hip_cooperative_groups.h>
#include <cstdio>
namespace cg = cooperative_groups;
namespace pg8 {
#define PG8_LAS __attribute__((address_space(3)))
typedef unsigned short bf16_t;
typedef short bf16x8 __attribute__((ext_vector_type(8)));
typedef float f32x4 __attribute__((ext_vector_type(4)));
typedef unsigned u32x4 __attribute__((ext_vector_type(4)));
constexpr int BM = 256, BK = 64, HALF = 128, HTB = HALF * BK * 2  , STAGE_BYTES = 8 * HTB, NXCD = 8, WGM = 4;

__host__ __device__ __forceinline__ int lds_byte(int r, int c) { const int st = (r >> 4) * 2 + (c >> 5), rr = r & 15, cc = c & 31, ob = rr * 64 + cc * 2; return st * 1024 + (ob ^ (((ob >> 9) & 1) << 5)); }
__host__ __device__ __forceinline__ void stage_rc(int b, int& R, int& C) { const int st = b / 1024, sb = b % 1024, swz = sb ^ (((sb >> 9) & 1) << 5); R = (st >> 1) * 16 + swz / 64; C = (st & 1) * 32 + (swz % 64) / 2; }
__host__ __device__ __forceinline__ int perm32(int rho) { const int n = rho >> 4, i = rho & 15; return 8 * (i >> 2) + 4 * n + (i & 3); }

struct Unit { int pm, pn; };
struct Gemm { const bf16_t* A; const bf16_t* Bt; int M, N, K; };

struct StaticOrder {
    int nM, nN, nwg, G, c, wgm;
    __host__ __device__ void init(int M, int N, int G_, int c_, int wgm_ = WGM) { nM = M / BM; nN = N / BM; nwg = nM * nN; G = G_; c = c_; wgm = wgm_; }
    __host__ __device__ bool next(int i, Unit& u) const {
        const long L = (long)i * G + c; if (L >= nwg) return false;
        int wgid = (int)L; { const int q = nwg / NXCD, r = nwg % NXCD, xcd = wgid % NXCD, off = wgid / NXCD; wgid = (xcd < r ? xcd * (q + 1) : r * (q + 1) + (xcd - r) * q) + off; }
        const int nig = wgm * nN, gid = wgid / nig, fm = gid * wgm, gsz = (nM - fm) < wgm ? (nM - fm) : wgm;
        u.pm = fm + ((wgid % nig) % gsz); u.pn = (wgid % nig) / gsz; return true;
    }
    __device__ __forceinline__ void a_ready(const Unit&) const {}
    __device__ __forceinline__ void done(const Unit&) const {}
};

__device__ __forceinline__ unsigned cvt_pk_bf16(float lo, float hi) { unsigned r; asm volatile("v_cvt_pk_bf16_f32 %0, %1, %2" : "=v"(r) : "v"(lo), "v"(hi)); return r; }
typedef float f32x2 __attribute__((ext_vector_type(2)));
__device__ __forceinline__ f32x2 gelu_pk(f32x2 v) {
    const f32x2 av = __builtin_elementwise_abs(v), d = av * 0.2316418882f + 1.0f;
    f32x2 t; t.x = __builtin_amdgcn_rcpf(d.x); t.y = __builtin_amdgcn_rcpf(d.y);
    f32x2 q = t * 0.5307027145f + (-0.7265760135f); q = q * t + 0.7107068705f; q = q * t + (-0.142248368f); q = q * t + 0.127414796f; q = q * t;
    const f32x2 s = (v * v) * (-0.72134752044f);
    f32x2 e; e.x = __builtin_amdgcn_exp2f(s.x); e.y = __builtin_amdgcn_exp2f(s.y);
    const f32x2 m = v * (q * e), r = v - m;
    f32x2 o; o.x = v.x < 0.f ? m.x : r.x; o.y = v.y < 0.f ? m.y : r.y; return o;
}

struct EpiF32 {
    static constexpr bool PERM = false, AFTER_DRAIN = false;
    float* C; int ldc; const float* bias;
    __device__ __forceinline__ void operator()(const f32x4 (&acc)[2][2][4][2], const Unit& u, int wr, int wc, int fr, int fq) const {
        const int row0 = u.pm * BM + wr * 64 + fr, col0 = u.pn * BM + wc * 32 + 4 * fq;
        f32x4 bv[2][2];
#pragma unroll
        for (int bj = 0; bj < 2; ++bj)
#pragma unroll
            for (int n = 0; n < 2; ++n) bv[bj][n] = bias ? *(const f32x4*)(bias + col0 + bj * HALF + n * 16) : (f32x4){0.f, 0.f, 0.f, 0.f};
#pragma unroll
        for (int ai = 0; ai < 2; ++ai)
#pragma unroll
            for (int m = 0; m < 4; ++m) { float* rowp = C + (size_t)(row0 + ai * HALF + m * 16) * ldc + col0;
#pragma unroll
                for (int bj = 0; bj < 2; ++bj)
#pragma unroll
                    for (int n = 0; n < 2; ++n) *(f32x4*)(rowp + bj * HALF + n * 16) = acc[ai][bj][m][n] + bv[bj][n]; }
    }
};
template <int ACT  > struct EpiBf16 {
    static constexpr bool PERM = true, AFTER_DRAIN = false;
    bf16_t* O; int ldc; const float* bias; int split_cols; size_t split_stride;
    __device__ __forceinline__ void operator()(const f32x4 (&acc)[2][2][4][2], const Unit& u, int wr, int wc, int fr, int fq) const {
        const int row0 = u.pm * BM + wr * 64 + fr; int colt = u.pn * BM; bf16_t* base = O;
        if (split_cols) { const int t = colt / split_cols; base += (size_t)t * split_stride; colt -= t * split_cols; }
        const int col0 = colt + wc * 32 + 8 * fq, bcol0 = u.pn * BM + wc * 32 + 8 * fq;
        f32x4 bv[2][2];
#pragma unroll
        for (int bj = 0; bj < 2; ++bj)
#pragma unroll
            for (int n = 0; n < 2; ++n) bv[bj][n] = bias ? *(const f32x4*)(bias + bcol0 + bj * HALF + 4 * n) : (f32x4){0.f, 0.f, 0.f, 0.f};
#pragma unroll
        for (int ai = 0; ai < 2; ++ai)
#pragma unroll
            for (int m = 0; m < 4; ++m) { bf16_t* rowp = base + (size_t)(row0 + ai * HALF + m * 16) * ldc + col0;
#pragma unroll
                for (int bj = 0; bj < 2; ++bj) { f32x4 v0 = acc[ai][bj][m][0] + bv[bj][0], v1 = acc[ai][bj][m][1] + bv[bj][1];
                    if (ACT == 1) { f32x2 a = gelu_pk((f32x2){v0[0], v0[1]}), b = gelu_pk((f32x2){v0[2], v0[3]}), c = gelu_pk((f32x2){v1[0], v1[1]}), d = gelu_pk((f32x2){v1[2], v1[3]});
                        v0 = (f32x4){a.x, a.y, b.x, b.y}; v1 = (f32x4){c.x, c.y, d.x, d.y}; }
                    if (ACT == 2) {
#pragma unroll
                        for (int j = 0; j < 4; ++j) { v0[j] = 0.5f * v0[j] * (1.0f + erff(v0[j] * 0.70710678f)); v1[j] = 0.5f * v1[j] * (1.0f + erff(v1[j] * 0.70710678f)); } }
                    u32x4 w; w.x = cvt_pk_bf16(v0[0], v0[1]); w.y = cvt_pk_bf16(v0[2], v0[3]); w.z = cvt_pk_bf16(v1[0], v1[1]); w.w = cvt_pk_bf16(v1[2], v1[3]);
                    *(u32x4*)(rowp + bj * HALF) = w; } }
    }
};

template <class Epi, class Sched, bool STAMP = false>
__device__ __forceinline__ void gemm_phase(PG8_LAS unsigned char* lds, const Gemm g, const Sched& S, const Epi& E, unsigned long long* stamps) {
    const int tid = threadIdx.x, wid = __builtin_amdgcn_readfirstlane(tid >> 6), lane = tid & 63, wr = wid >> 2, wc = wid & 3, fr = lane & 15, fq = lane >> 4;
    const int K = g.K, nt = K / BK;
    int ts_lo = 0, ts_hi = 0, nts = 0; const unsigned long long rt_entry = STAMP ? (unsigned long long)wall_clock64() : 0ull;
#define PG8_STAMP() do { if (STAMP && wid == 0 && nts < 64) { const unsigned long long _c = (unsigned long long)clock64(); \
        ts_lo = (lane == nts) ? (int)(unsigned)_c : ts_lo; ts_hi = (lane == nts) ? (int)(unsigned)(_c >> 32) : ts_hi; ++nts; } } while (0)
    PG8_STAMP();
    unsigned voffA[2], voffB[2];
#pragma unroll
    for (int i = 0; i < 2; ++i) { int R, C; stage_rc(tid * 16 + i * 8192, R, C); const int Rb = Epi::PERM ? ((R & ~31) + perm32(R & 31)) : R;
        voffA[i] = (unsigned)(R * K + C) * 2u; voffB[i] = (unsigned)(Rb * K + C) * 2u; }
    const size_t kstep = (size_t)(BK * 2);
    const size_t hstep = (size_t)HALF * K * 2;
    const size_t tstep = 2 * hstep;
    const unsigned ldsw = (unsigned)wid * 1024u;
    const int aoff = lds_byte(wr * 64 + fr, fq * 8), boff = lds_byte(wc * 32 + fr, fq * 8);
#define PG8_SA(b, h) (((b) * 2 + (h)) * HTB)
#define PG8_SB(b, h) ((4 + (b) * 2 + (h)) * HTB)
#define PG8_STAGE(bufoff, gbase, voff) do { _Pragma("unroll") for (int _i = 0; _i < 2; ++_i) \
        __builtin_amdgcn_global_load_lds((const unsigned*)((const char*)(gbase) + (voff)[_i]), (PG8_LAS unsigned*)(lds + (bufoff) + ldsw + _i * 8192), 16, 0, 0); } while (0)
#define PG8_LDA(dst, b, h) do { _Pragma("unroll") for (int m = 0; m < 4; ++m) _Pragma("unroll") for (int k = 0; k < 2; ++k) dst[m][k] = *(const PG8_LAS bf16x8*)(lds + PG8_SA(b, h) + aoff + m * 2048 + k * 1024); } while (0)
#define PG8_LDB(dst, b, h) do { _Pragma("unroll") for (int n = 0; n < 2; ++n) _Pragma("unroll") for (int k = 0; k < 2; ++k) dst[n][k] = *(const PG8_LAS bf16x8*)(lds + PG8_SB(b, h) + boff + n * 2048 + k * 1024); } while (0)
#define PG8_MMA(ai, bj, At, Bt) do { __builtin_amdgcn_s_setprio(1); _Pragma("unroll") for (int m = 0; m < 4; ++m) _Pragma("unroll") for (int n = 0; n < 2; ++n) _Pragma("unroll") for (int k = 0; k < 2; ++k) \
        acc[ai][bj][m][n] = __builtin_amdgcn_mfma_f32_16x16x32_bf16(Bt[n][k], At[m][k], acc[ai][bj][m][n], 0, 0, 0); __builtin_amdgcn_s_setprio(0); } while (0)
#define PG8_WAIT_V(n) asm volatile("s_waitcnt vmcnt(" #n ")" ::: "memory")
#define PG8_WAIT_L(n) asm volatile("s_waitcnt lgkmcnt(" #n ")" ::: "memory")
#define PG8_BAR __builtin_amdgcn_s_barrier()
#define PG8_SCHED __builtin_amdgcn_sched_barrier(0)
    Unit cur, nxt; int ui = 0;
    if (!S.next(0, cur)) return;
    f32x4 acc[2][2][4][2];
#pragma unroll
    for (int a = 0; a < 2; ++a)
#pragma unroll
        for (int b = 0; b < 2; ++b)
#pragma unroll
            for (int m = 0; m < 4; ++m)
#pragma unroll
                for (int n = 0; n < 2; ++n) acc[a][b][m][n] = (f32x4){0.f, 0.f, 0.f, 0.f};
    bf16x8 At[4][2], B0[2][2], B1[2][2];
    const char* cA = (const char*)g.A + (size_t)cur.pm * tstep; const char* cB = (const char*)g.Bt + (size_t)cur.pn * tstep;
    S.a_ready(cur);
    PG8_STAGE(PG8_SB(0, 0), cB, voffB); PG8_STAGE(PG8_SA(0, 0), cA, voffA); PG8_STAGE(PG8_SB(0, 1), cB + hstep, voffB); PG8_STAGE(PG8_SA(0, 1), cA + hstep, voffA);
    if (wr == 1) PG8_BAR;
    PG8_WAIT_V(4); PG8_BAR;
    PG8_STAGE(PG8_SB(1, 0), cB + kstep, voffB); PG8_STAGE(PG8_SA(1, 0), cA + kstep, voffA); PG8_STAGE(PG8_SB(1, 1), cB + hstep + kstep, voffB);
    PG8_WAIT_V(6); PG8_BAR;
    PG8_STAMP();
    for (;;) {
        const bool has_next = S.next(ui + 1, nxt);
        const char* nA = has_next ? (const char*)g.A + (size_t)nxt.pm * tstep : cA; const char* nB = has_next ? (const char*)g.Bt + (size_t)nxt.pn * tstep : cB;
        for (int t = 0; t < nt; t += 2) {
            const bool last = (t == nt - 2);
            const char* a1 = cA + (size_t)(t + 1) * kstep;
            const char* a2 = last ? nA : cA + (size_t)(t + 2) * kstep; const char* b2 = last ? nB : cB + (size_t)(t + 2) * kstep;
            const char* a3 = a2 + kstep; const char* b3 = b2 + kstep;
            if (last && has_next) S.a_ready(nxt);
            PG8_LDB(B0, 0, 0); PG8_SCHED; PG8_LDA(At, 0, 0); PG8_STAGE(PG8_SA(1, 1), a1 + hstep, voffA);
            PG8_WAIT_L(8); PG8_BAR; PG8_WAIT_L(0); PG8_MMA(0, 0, At, B0); PG8_BAR; PG8_SCHED;
            PG8_LDB(B1, 0, 1); PG8_STAGE(PG8_SB(0, 0), b2, voffB);
            PG8_BAR; PG8_WAIT_L(0); PG8_MMA(0, 1, At, B1); PG8_BAR;
            PG8_LDA(At, 0, 1); PG8_STAGE(PG8_SA(0, 0), a2, voffA);
            PG8_BAR; PG8_WAIT_L(0); PG8_MMA(1, 0, At, B0); PG8_BAR; PG8_SCHED;
            PG8_STAGE(PG8_SB(0, 1), b2 + hstep, voffB);
            PG8_WAIT_V(6); PG8_BAR; PG8_MMA(1, 1, At, B1); PG8_BAR;
            PG8_LDB(B0, 1, 0); PG8_SCHED; PG8_LDA(At, 1, 0); PG8_STAGE(PG8_SA(0, 1), a2 + hstep, voffA);
            PG8_WAIT_L(8); PG8_BAR; PG8_WAIT_L(0); PG8_MMA(0, 0, At, B0); PG8_BAR; PG8_SCHED;
            PG8_LDB(B1, 1, 1); PG8_STAGE(PG8_SB(1, 0), b3, voffB);
            PG8_BAR; PG8_WAIT_L(0); PG8_MMA(0, 1, At, B1); PG8_BAR;
            PG8_LDA(At, 1, 1); PG8_STAGE(PG8_SA(1, 0), a3, voffA);
            PG8_BAR; PG8_WAIT_L(0); PG8_MMA(1, 0, At, B0); PG8_BAR; PG8_SCHED;
            PG8_STAGE(PG8_SB(1, 1), b3 + hstep, voffB);
            PG8_WAIT_V(6); PG8_BAR; PG8_MMA(1, 1, At, B1); PG8_BAR;
        }
        PG8_STAMP();
        if constexpr (!Epi::AFTER_DRAIN) { E(acc, cur, wr, wc, fr, fq); S.done(cur); }
        PG8_STAMP();
        if (!has_next) break;
#pragma unroll
        for (int a = 0; a < 2; ++a)
#pragma unroll
            for (int b = 0; b < 2; ++b)
#pragma unroll
                for (int m = 0; m < 4; ++m)
#pragma unroll
                    for (int n = 0; n < 2; ++n) acc[a][b][m][n] = (f32x4){0.f, 0.f, 0.f, 0.f};
        cur = nxt; cA = nA; cB = nB; ++ui;
    }
    PG8_WAIT_V(0);
    if (wr == 0) PG8_BAR;
    PG8_BAR;
    if constexpr (Epi::AFTER_DRAIN) { E.fused(acc, cur, wr, wc, fr, fq, lds, wid, lane); S.done(cur); }
    PG8_STAMP();
    if (STAMP && wid == 0) { stamps[lane] = lane < nts ? (((unsigned long long)(unsigned)ts_hi << 32) | (unsigned)ts_lo) : 0ull;
        if (lane == 62) stamps[62] = rt_entry; if (lane == 63) stamps[63] = (unsigned long long)wall_clock64(); }
#undef PG8_STAMP
#undef PG8_SA
#undef PG8_SB
#undef PG8_STAGE
#undef PG8_LDA
#undef PG8_LDB
#undef PG8_MMA
#undef PG8_WAIT_V
#undef PG8_WAIT_L
#undef PG8_BAR
#undef PG8_SCHED
}
}
#ifndef WGM_MAIN
#define WGM_MAIN 4
#endif
#ifndef WGM_OUT
#define WGM_OUT 4
#endif

constexpr int D = 1024, NB = 8, T = 4096, MTOK = NB * T;
constexpr int NP = 3840;
constexpr int CA_U = 0, CA_V = 512, CA_G = 1024;
constexpr int CB0 = 1536;
constexpr int CB_R = 0, CB_K = 512, CB_V = 1024, CB_G = 1536, CB_WD = 2048;
constexpr float ALPHA = 1.189207115f;
constexpr float LN_EPS = 1e-5f, GN_EPS = 64e-5f;
constexpr int XB_LDS_OFF = 160256;
constexpr int LDS_BYTES = 160256 + 16;

typedef unsigned short bf16_t;
typedef short bf16x8 __attribute__((ext_vector_type(8)));
typedef float f32x4 __attribute__((ext_vector_type(4)));
typedef float f32x2 __attribute__((ext_vector_type(2)));
typedef float f32x16 __attribute__((ext_vector_type(16)));
typedef unsigned u32x4 __attribute__((ext_vector_type(4)));
typedef unsigned u32x2 __attribute__((ext_vector_type(2)));
#define DI __device__ __forceinline__
#define MFMA32(a, b, c) __builtin_amdgcn_mfma_f32_32x32x16_bf16((a), (b), (c), 0, 0, 0)

DI float bf2f(bf16_t v) { return __uint_as_float(((unsigned)v) << 16); }
DI float bflo(unsigned w) { return __uint_as_float(w << 16); }
DI float bfhi(unsigned w) { return __uint_as_float(w & 0xffff0000u); }
typedef __bf16 bf16x2_t __attribute__((ext_vector_type(2)));
DI unsigned pk2(float lo, float hi) { const f32x2 v = {lo, hi}; return __builtin_bit_cast(unsigned, __builtin_convertvector(v, bf16x2_t)); }
DI bf16_t f2bf(float f) { return (bf16_t)(pk2(f, f) & 0xffffu); }
#define LBAR() asm volatile("s_waitcnt lgkmcnt(0)\n\ts_barrier" ::: "memory")
DI float rcpf_(float x) { return __builtin_amdgcn_rcpf(x); }
DI float sigm(float x) { return rcpf_(1.f + __expf(-x)); }
DI float silu(float x) { return x * rcpf_(1.f + __expf(-x)); }
DI float gelu_tanh(float x) { const float u = 1.5957691216f * (x + 0.044715f * x * x * x); return x * rcpf_(1.f + __expf(-u)); }
DI int crow(int reg, int h) { return (reg & 3) + 8 * (reg >> 2) + 4 * h; }
template <int CTRL> DI float dppf(float x) { return __int_as_float(__builtin_amdgcn_update_dpp(0, __float_as_int(x), CTRL, 0xF, 0xF, true)); }
DI float reduce16(float x) { x += dppf<0xB1>(x); x += dppf<0x4E>(x); x += dppf<0x141>(x); x += dppf<0x140>(x); return x; }
DI float reduce32(float x) { x = reduce16(x); x += __shfl_xor(x, 16); return x; }

struct Params {
    const float *x, *c, *w_ada, *b_ada, *w_in, *mu_b, *ln_v_g, *ln_v_b, *w_spatial, *b_spatial, *w0, *w_up, *a0, *a_up, *k_k, *k_a, *r_k, *gn_g, *gn_b, *w_out, *ln_g, *ln_b;
    float* out;
    float* mod;
    bf16_t* hbf;
    bf16_t* wt_in;
    bf16_t* wt_out;
    bf16_t* wupT;
    bf16_t* aupT;
    bf16_t* p;
    bf16_t *An, *Bn, *Kn, *Rn, *At, *Bt, *Kt, *Vt;
    bf16_t *sv, *sg;
    float *gC, *bonus;
    bf16_t *cG, *cR;
    bf16_t *cH, *cY;
    bf16_t* cS;
    float* y;
    bf16_t* pre;
    unsigned* xbar;
    int phase_lo, phase_hi;
};

DI void tr_tile(const float* src, int ld, int ncols, bf16_t* dst, int ldd, int kt, int nt, float* red) {
    const int tid = threadIdx.x, kr = tid >> 3, c8 = (tid & 7) * 8, n0 = nt * 64;
    f32x4 a = {0.f, 0.f, 0.f, 0.f}, b = a;
    if (n0 + c8 < ncols) { const float* s = src + (size_t)(kt * 64 + kr) * ld + n0 + c8; a = *(const f32x4*)s; b = *(const f32x4*)(s + 4); }
    float* tr = red + kr * 65 + c8;
    tr[0] = a[0]; tr[1] = a[1]; tr[2] = a[2]; tr[3] = a[3]; tr[4] = b[0]; tr[5] = b[1]; tr[6] = b[2]; tr[7] = b[3];
    __syncthreads();
    const int n = tid >> 3, kgp = (tid & 7) * 8;
    u32x4 w;
    w.x = pk2(red[(kgp + 0) * 65 + n], red[(kgp + 1) * 65 + n]); w.y = pk2(red[(kgp + 2) * 65 + n], red[(kgp + 3) * 65 + n]);
    w.z = pk2(red[(kgp + 4) * 65 + n], red[(kgp + 5) * 65 + n]); w.w = pk2(red[(kgp + 6) * 65 + n], red[(kgp + 7) * 65 + n]);
    *(u32x4*)(dst + (size_t)(n0 + n) * ldd + kt * 64 + kgp) = w;
    __syncthreads();
}
__device__ void phase0(const Params& P, unsigned char* lds) {
    float* sc = (float*)lds;
    float* red = sc + 8192;
    const int tid = threadIdx.x;
    for (int i = tid; i < 8192; i += 512) sc[i] = silu(P.c[i]);
    __syncthreads();
    constexpr int NMOD = 192, NTIN = 960, NTOUT = 256, NTUP = 16;
    for (int it = blockIdx.x; it < NMOD + NTIN + NTOUT + NTUP; it += gridDim.x) {
        if (it < NMOD) {
            const int cl = tid & 15, n = it * 16 + cl, kg = tid >> 4;
            float acc[8];
#pragma unroll
            for (int b = 0; b < 8; ++b) acc[b] = 0.f;
            for (int i = 0; i < 32; ++i) {
                const int k = kg + 32 * i; const float w = P.w_ada[(size_t)k * 3072 + n];
#pragma unroll
                for (int b = 0; b < 8; ++b) acc[b] += sc[b * 1024 + k] * w;
            }
#pragma unroll
            for (int b = 0; b < 8; ++b) red[(kg * 16 + cl) * 8 + b] = acc[b];
            __syncthreads();
            if (tid < 128) { const int b = tid >> 4, c2 = tid & 15; float s = 0.f; for (int g = 0; g < 32; ++g) s += red[(g * 16 + c2) * 8 + b];
                P.mod[b * 3072 + it * 16 + c2] = s + P.b_ada[it * 16 + c2]; }
            __syncthreads();
        } else {
            int j = it - NMOD;
            if (j < NTIN) tr_tile(P.w_in, 3712, 3712, P.wt_in, 1024, j & 15, j >> 4, red);
            else if (j < NTIN + NTOUT) { j -= NTIN; tr_tile(P.w_out, 1024, 1024, P.wt_out, 1024, j & 15, j >> 4, red); }
            else if (j < NTIN + NTOUT + 8) { j -= NTIN + NTOUT; tr_tile(P.w_up, 512, 512, P.wupT, 64, 0, j & 7, red); }
            else { j -= NTIN + NTOUT + 8; tr_tile(P.a_up, 512, 512, P.aupT, 64, 0, j & 7, red); }
        }
    }
}

__device__ void phase1(const Params& P) {
    for (size_t idx = (size_t)blockIdx.x * 512 + threadIdx.x; idx < (size_t)MTOK * 128; idx += (size_t)gridDim.x * 512) {
        const int m = (int)(idx >> 7), c8 = (int)(idx & 127) * 8, b = m >> 12;
        const float* xp = P.x + (size_t)m * D + c8; const float* sh = P.mod + b * 3072 + c8; const float* scp = sh + 1024;
        const f32x4 x0 = *(const f32x4*)xp, x1 = *(const f32x4*)(xp + 4), s0 = *(const f32x4*)sh, s1 = *(const f32x4*)(sh + 4), c0 = *(const f32x4*)scp, c1 = *(const f32x4*)(scp + 4);
        const f32x4 h0 = x0 * (1.f + c0) + s0, h1 = x1 * (1.f + c1) + s1;
        u32x4 w; w.x = pk2(h0[0], h0[1]); w.y = pk2(h0[2], h0[3]); w.z = pk2(h1[0], h1[1]); w.w = pk2(h1[2], h1[3]);
        *(u32x4*)(P.hbf + (size_t)m * D + c8) = w;
    }
}

__device__ void phase3a(const Params& P, unsigned char* lds) {
    bf16_t* Wm = (bf16_t*)lds;
    bf16_t* Vt = Wm + 128 * 136;
    bf16_t* UG = Vt + 64 * 136;
    bf16_t* OT = UG + 128 * 72;
    float* BS = (float*)(OT + 128 * 72);
    const int tid = threadIdx.x, wv = tid >> 6, lane = tid & 63, r = lane & 31, h = lane >> 5;
    const int st = tid >> 2, sdq = (tid & 3) * 16;
    int cur_g = -1;
    u32x4 qv[2], qu[2], qg[2];
    auto gload = [&](int it_) { const bf16_t* src = P.p + ((size_t)(it_ >> 3) * 128 + st) * NP + 64 * (it_ & 7) + sdq;
        qv[0] = *(const u32x4*)(src + CA_V); qv[1] = *(const u32x4*)(src + CA_V + 8); qu[0] = *(const u32x4*)(src + CA_U); qu[1] = *(const u32x4*)(src + CA_U + 8);
        qg[0] = *(const u32x4*)(src + CA_G); qg[1] = *(const u32x4*)(src + CA_G + 8); };
    if ((int)blockIdx.x < 2048) gload(blockIdx.x);
    for (int it = blockIdx.x; it < 2048; it += gridDim.x) {
        const int g = it & 7, bc = it >> 3; const size_t row0 = (size_t)bc * 128;
        if (g != cur_g) {
            cur_g = g;
            for (int e = tid; e < 2048; e += 512) {
                const int t = e >> 4, s8 = (e & 15) * 8; const float* sp = P.w_spatial + ((size_t)g * 128 + t) * 128 + s8;
                const f32x4 a = *(const f32x4*)sp, b = *(const f32x4*)(sp + 4);
                float v[8] = {a[0], a[1], a[2], a[3], b[0], b[1], b[2], b[3]};
#pragma unroll
                for (int j = 0; j < 8; ++j) v[j] = (s8 + j <= t) ? v[j] : 0.f;
                *(u32x4*)(Wm + t * 136 + s8) = (u32x4){pk2(v[0], v[1]), pk2(v[2], v[3]), pk2(v[4], v[5]), pk2(v[6], v[7])};
            }
            if (tid < 128) BS[tid] = P.b_spatial[g * 128 + tid];
        }
        {
            const unsigned wq[8] = {qv[0].x, qv[0].y, qv[0].z, qv[0].w, qv[1].x, qv[1].y, qv[1].z, qv[1].w};
            float v[16];
            float s = 0.f;
#pragma unroll
            for (int j = 0; j < 8; ++j) { v[2 * j] = gelu_tanh(bflo(wq[j])); v[2 * j + 1] = gelu_tanh(bfhi(wq[j])); s += v[2 * j] + v[2 * j + 1]; }
            s += dppf<0xB1>(s); s += dppf<0x4E>(s);
            const float mean = s * (1.f / 64.f);
            float q = 0.f;
#pragma unroll
            for (int j = 0; j < 16; ++j) { v[j] -= mean; q += v[j] * v[j]; }
            q += dppf<0xB1>(q); q += dppf<0x4E>(q);
            const float rstd = rsqrtf(q * (1.f / 64.f) + LN_EPS);
#pragma unroll
            for (int j = 0; j < 16; ++j) { const int d = sdq + j; Vt[d * 136 + st] = f2bf(v[j] * rstd * P.ln_v_g[g * 64 + d] + P.ln_v_b[g * 64 + d]); }
            const unsigned wu[8] = {qu[0].x, qu[0].y, qu[0].z, qu[0].w, qu[1].x, qu[1].y, qu[1].z, qu[1].w}, wg[8] = {qg[0].x, qg[0].y, qg[0].z, qg[0].w, qg[1].x, qg[1].y, qg[1].z, qg[1].w};
            unsigned o[8];
#pragma unroll
            for (int j = 0; j < 8; ++j) o[j] = pk2(gelu_tanh(bflo(wu[j])) * silu(bflo(wg[j])), gelu_tanh(bfhi(wu[j])) * silu(bfhi(wg[j])));
            *(u32x4*)(UG + st * 72 + sdq) = (u32x4){o[0], o[1], o[2], o[3]}; *(u32x4*)(UG + st * 72 + sdq + 8) = (u32x4){o[4], o[5], o[6], o[7]};
        }
        __builtin_amdgcn_sched_barrier(0);
        if (it + (int)gridDim.x < 2048) gload(it + gridDim.x);
        LBAR();
        const int t0 = 32 * (wv >> 1), d0 = 32 * (wv & 1);
        f32x16 acc;
#pragma unroll
        for (int i = 0; i < 16; ++i) acc[i] = 0.f;
        for (int ks = 0; ks < 8; ++ks) {
            if (16 * ks > t0 + 31) break;
            const bf16x8 a = *(const bf16x8*)(Wm + (t0 + r) * 136 + 16 * ks + 8 * h);
            const bf16x8 b = *(const bf16x8*)(Vt + (d0 + r) * 136 + 16 * ks + 8 * h);
            acc = MFMA32(a, b, acc);
        }
#pragma unroll
        for (int i = 0; i < 16; ++i) {
            const int t = t0 + crow(i, h), d = d0 + r;
            OT[t * 72 + d] = f2bf((acc[i] + BS[t]) * bf2f(UG[t * 72 + d]));
        }
        LBAR();
        {   const u32x4 o0 = *(const u32x4*)(OT + st * 72 + sdq), o1 = *(const u32x4*)(OT + st * 72 + sdq + 8);
            bf16_t* dst = P.hbf + (row0 + st) * D + 64 * g + sdq;
            *(u32x4*)dst = o0; *(u32x4*)(dst + 8) = o1; }
    }
    LBAR();
}

DI float xs_at(const Params& P, unsigned row, int cb) {
    const unsigned o = row * (unsigned)NP + (unsigned)(CB0 + cb); const float cur = bf2f(P.p[o]);
    const float prev = (row & 4095u) ? bf2f(P.p[o - (unsigned)NP]) : 0.f;
    return cur + P.mu_b[cb] * (prev - cur);
}
__device__ void phase3b(const Params& P, unsigned char* lds) {
    bf16_t* Awd = (bf16_t*)lds;
    bf16_t* Aad = Awd + 64 * 72;
    float* ssn = (float*)(Aad + 64 * 72);
    const int tid = threadIdx.x, wv = tid >> 6, lane = tid & 63, r = lane & 31, h = lane >> 5;
    float* part = ssn + 512 + wv * (64 * 33);
    for (int it = blockIdx.x; it < 512; it += gridDim.x) {
        const size_t m0 = (size_t)it * 64;
        {
            const int t = tid >> 3, c16 = (tid & 7) * 16; const size_t row = m0 + t;
            const bf16_t* q = P.p + row * NP + CB0 + CB_WD + c16; const bool hasprev = (row & 4095) != 0;
            const u32x4 z = {0u, 0u, 0u, 0u};
            const u32x4 c0 = *(const u32x4*)q, c1 = *(const u32x4*)(q + 8);
            const u32x4 p0 = hasprev ? *(const u32x4*)(q - NP) : z, p1 = hasprev ? *(const u32x4*)(q - NP + 8) : z;
            const unsigned cw[8] = {c0.x, c0.y, c0.z, c0.w, c1.x, c1.y, c1.z, c1.w}, pw[8] = {p0.x, p0.y, p0.z, p0.w, p1.x, p1.y, p1.z, p1.w};
            unsigned ow[8];
#pragma unroll
            for (int j = 0; j < 8; ++j) {
                const float m_lo = P.mu_b[CB_WD + c16 + 2 * j], m_hi = P.mu_b[CB_WD + c16 + 2 * j + 1];
                float lo = bflo(cw[j]), hi = bfhi(cw[j]);
                lo += m_lo * (bflo(pw[j]) - lo); hi += m_hi * (bfhi(pw[j]) - hi);
                if (c16 < 64) { lo = tanhf(lo); hi = tanhf(hi); }
                ow[j] = pk2(lo, hi);
            }
            bf16_t* dst = (c16 < 64) ? (Awd + t * 72 + c16) : (Aad + t * 72 + (c16 - 64));
            *(u32x4*)dst = (u32x4){ow[0], ow[1], ow[2], ow[3]}; *(u32x4*)(dst + 8) = (u32x4){ow[4], ow[5], ow[6], ow[7]};
        }
#pragma unroll 2
        for (int rd = 0; rd < 16; ++rd) {
            const int pair = rd * 32 + (tid >> 4), t = pair >> 3, hd = pair & 7, l16 = tid & 15, n = hd * 64 + l16 * 4; const unsigned row = (unsigned)m0 + t;
            const unsigned o = row * (unsigned)NP + (unsigned)(CB0 + CB_K + n);
            const u32x2 cu = *(const u32x2*)(P.p + o); u32x2 pv = {0u, 0u}; if (row & 4095u) pv = *(const u32x2*)(P.p + o - (unsigned)NP);
            const f32x4 mu = *(const f32x4*)(P.mu_b + CB_K + n), kq = *(const f32x4*)(P.k_k + n);
            const float c4[4] = {bflo(cu.x), bfhi(cu.x), bflo(cu.y), bfhi(cu.y)}, p4[4] = {bflo(pv.x), bfhi(pv.x), bflo(pv.y), bfhi(pv.y)};
            float s = 0.f;
#pragma unroll
            for (int j = 0; j < 4; ++j) { const float kk = (c4[j] + mu[j] * (p4[j] - c4[j])) * kq[j]; s += kk * kk; }
            s = reduce16(s);
            if (l16 == 0) ssn[t * 8 + hd] = rsqrtf(s + 1e-12f);
        }
        __syncthreads();
        const int hd = wv;
        const unsigned cbase = (unsigned)(((it >> 6) * 8 + hd) * 64 + (it & 63)) * 4096u;
#pragma unroll 1
        for (int nt = 0; nt < 2; ++nt) {
            const int j = nt * 32 + r, n = hd * 64 + j;
            const float w0n = P.w0[n], a0n = P.a0[n], kkn_ = P.k_k[n], kan = P.k_a[n], rkn = P.r_k[n];
            float run = 0.f;
#pragma unroll 1
            for (int tt = 0; tt < 2; ++tt) {
                f32x16 aw, aa;
#pragma unroll
                for (int i = 0; i < 16; ++i) { aw[i] = 0.f; aa[i] = 0.f; }
#pragma unroll
                for (int ks = 0; ks < 4; ++ks) {
                    const bf16x8 bw = *(const bf16x8*)(P.wupT + (unsigned)((hd * 64 + nt * 32 + r) * 64 + 16 * ks + 8 * h));
                    const bf16x8 ba = *(const bf16x8*)(P.aupT + (unsigned)((hd * 64 + nt * 32 + r) * 64 + 16 * ks + 8 * h));
                    const bf16x8 fw = *(const bf16x8*)(Awd + (tt * 32 + r) * 72 + 16 * ks + 8 * h);
                    const bf16x8 fa = *(const bf16x8*)(Aad + (tt * 32 + r) * 72 + 16 * ks + 8 * h);
                    aw = MFMA32(fw, bw, aw); aa = MFMA32(fa, ba, aa);
                }
#pragma unroll
                for (int i = 0; i < 16; ++i) {
                    const float z = -(w0n + aw[i]);
                    const float sp = fmaxf(z, 0.f) + log1pf(__expf(-fabsf(z)));
                    aw[i] = -__expf(-sp - 0.5f);
                }
                f32x16 cum;
#pragma unroll
                for (int ib = 0; ib < 4; ++ib) {
                    const float l0 = aw[4 * ib], l1 = l0 + aw[4 * ib + 1], l2 = l1 + aw[4 * ib + 2], l3 = l2 + aw[4 * ib + 3];
                    const float pg = __shfl_xor(l3, 32);
                    const float off = run + (h ? pg : 0.f);
                    cum[4 * ib] = off + l0; cum[4 * ib + 1] = off + l1; cum[4 * ib + 2] = off + l2; cum[4 * ib + 3] = off + l3;
                    run += l3 + pg;
                }
#pragma unroll
                for (int ib = 0; ib < 4; ++ib) {
                    float tA[4], tB[4], tK[4], tV[4];
#pragma unroll
                    for (int e = 0; e < 4; ++e) {
                        const int i = 4 * ib + e, t = tt * 32 + 8 * ib + 4 * h + e; const unsigned row = (unsigned)m0 + t;
                        const float xr = xs_at(P, row, CB_R + n), xk = xs_at(P, row, CB_K + n), xv = xs_at(P, row, CB_V + n), xg = xs_at(P, row, CB_G + n);
                        const float a = sigm(a0n + aa[i]);
                        const float kk = xk * kkn_ * ssn[t * 8 + hd];
                        const float kp = xk * (1.f + (a - 1.f) * kan), bq = kk * a;
                        const float ec = cum[i], lw = aw[i];
                        const float gi = __expf(-ec);
                        const float an = -kk * __expf(ec - lw);
                        const unsigned o = cbase + (unsigned)(t * 64 + j);
                        tA[e] = an; tB[e] = bq * gi; tK[e] = kp * gi; tV[e] = xv;
                        P.An[o] = f2bf(an); P.Bn[o] = f2bf(tB[e]); P.Kn[o] = f2bf(tK[e]); P.Rn[o] = f2bf(xr * __expf(ec));
                        P.sv[row * 512u + n] = f2bf(xv); P.sg[row * 512u + n] = f2bf(silu(xg));
                        { float* pp = part + t * 33 + r; const float pv0 = nt ? *pp : 0.f; *pp = pv0 + xr * kp * rkn; }
                    }
                    const unsigned ot = cbase + (unsigned)(j * 64 + tt * 32 + 8 * ib + 4 * h);
                    *(u32x2*)(P.At + ot) = (u32x2){pk2(tA[0], tA[1]), pk2(tA[2], tA[3])};
                    *(u32x2*)(P.Bt + ot) = (u32x2){pk2(tB[0], tB[1]), pk2(tB[2], tB[3])};
                    *(u32x2*)(P.Kt + ot) = (u32x2){pk2(tK[0], tK[1]), pk2(tK[2], tK[3])};
                    *(u32x2*)(P.Vt + ot) = (u32x2){pk2(tV[0], tV[1]), pk2(tV[2], tV[3])};
                    asm volatile("" ::: "memory");
                }
            }
            if (h == 0) P.gC[(cbase >> 6) + j] = __expf(run);
        }
        {
            float s = 0.f;
            for (int q = 0; q < 32; ++q) s += part[lane * 33 + q];
            P.bonus[(m0 + lane) * 8 + hd] = s;
        }
        __syncthreads();
    }
}

DI f32x4 mfma16(bf16x8 a, bf16x8 b, f32x4 c) { return __builtin_amdgcn_mfma_f32_16x16x32_bf16(a, b, c, 0, 0, 0); }
struct TileCtx { int mt, nt0, l16, quad; };
#define FRAG(base, ld, row, ks) (*(const bf16x8*)((base) + (size_t)(row) * (ld) + 32 * (ks) + 8 * c.quad))
#define MM2(acc, A, lda, B, ldb) do { const bf16x8 _a0 = FRAG(A, lda, 16 * c.mt + c.l16, 0), _a1 = FRAG(A, lda, 16 * c.mt + c.l16, 1); \
    _Pragma("unroll") for (int _e = 0; _e < 2; ++_e) { const bf16x8 _b0 = FRAG(B, ldb, 16 * (c.nt0 + _e) + c.l16, 0), _b1 = FRAG(B, ldb, 16 * (c.nt0 + _e) + c.l16, 1); \
        acc[_e] = mfma16(_a0, _b0, acc[_e]); acc[_e] = mfma16(_a1, _b1, acc[_e]); } } while (0)
DI void storeT_bf(bf16_t* Z, int ld, const TileCtx& c, int e, f32x4 v) { *(u32x2*)(Z + (size_t)(16 * (c.nt0 + e) + c.l16) * ld + 16 * c.mt + 4 * c.quad) = (u32x2){pk2(v[0], v[1]), pk2(v[2], v[3])}; }
DI void storeN_bf(bf16_t* Z, int ld, const TileCtx& c, int e, f32x4 v) {
#pragma unroll
    for (int jj = 0; jj < 4; ++jj) Z[(size_t)(16 * c.mt + 4 * c.quad + jj) * ld + 16 * (c.nt0 + e) + c.l16] = f2bf(v[jj]); }
DI f32x4 loadT_bf(const bf16_t* Z, int ld, const TileCtx& c, int e) { const u32x2 w = *(const u32x2*)(Z + (size_t)(16 * (c.nt0 + e) + c.l16) * ld + 16 * c.mt + 4 * c.quad); return (f32x4){bflo(w.x), bfhi(w.x), bflo(w.y), bfhi(w.y)}; }
constexpr int LQ = 72, LMB = 64 * LQ;
template <int KLEN> DI f32x4 mm1(f32x4 acc, const bf16_t* A, int arow, const bf16_t* B, int brow, int koff, int l16, int quad) {
    const bf16x8 zz = {0, 0, 0, 0, 0, 0, 0, 0};
    bf16x8 a = zz, b = zz;
    if (KLEN == 32 || quad < 2) { a = *(const bf16x8*)(A + (arow + l16) * LQ + koff + 8 * quad); b = *(const bf16x8*)(B + (brow + l16) * LQ + koff + 8 * quad); }
    return mfma16(a, b, acc);
}
DI void st1T(bf16_t* Z, int mrow, int nrow, int l16, int quad, f32x4 v) { *(u32x2*)(Z + (nrow + l16) * LQ + mrow + 4 * quad) = (u32x2){pk2(v[0], v[1]), pk2(v[2], v[3])}; }
DI void st1N(bf16_t* Z, int mrow, int nrow, int l16, int quad, f32x4 v) {
#pragma unroll
    for (int jj = 0; jj < 4; ++jj) Z[(mrow + 4 * quad + jj) * LQ + nrow + l16] = f2bf(v[jj]); }
__device__ void phase4a(const Params& P, unsigned char* lds) {
    bf16_t* L0 = (bf16_t*)lds;
    bf16_t *Ma = L0, *Tm = L0 + LMB, *TmT = L0 + 2 * LMB, *Zt = L0 + 3 * LMB;
    bf16_t *Lak = L0 + 6 * LMB, *Lrb = L0 + 7 * LMB, *Lrk = L0 + 8 * LMB, *W2T = L0 + 9 * LMB, *PT = L0 + 10 * LMB, *QT = L0 + 11 * LMB;
    const int tid = threadIdx.x, wv = tid >> 6, lane = tid & 63;
    TileCtx c; c.mt = wv >> 1; c.nt0 = (wv & 1) * 2; c.l16 = lane & 15; c.quad = lane >> 4;
    const f32x4 z = {0.f, 0.f, 0.f, 0.f};
    for (int ci = blockIdx.x; ci < 4096; ci += gridDim.x) {
        const size_t cb = (size_t)ci * 4096;
        const bf16_t *An = P.An + cb, *Bn = P.Bn + cb, *Kn = P.Kn + cb, *Rn = P.Rn + cb, *At = P.At + cb, *Bt = P.Bt + cb, *Kt = P.Kt + cb, *Vt = P.Vt + cb;
        {
            f32x4 ab[2] = {z, z}, ak[2] = {z, z}, rb[2] = {z, z}, rk[2] = {z, z};
            MM2(ab, Bn, 64, An, 64); MM2(ak, Kn, 64, An, 64); MM2(rb, Bn, 64, Rn, 64); MM2(rk, Kn, 64, Rn, 64);
#pragma unroll
            for (int e = 0; e < 2; ++e) {
                const int t = 16 * (c.nt0 + e) + c.l16;
#pragma unroll
                for (int jj = 0; jj < 4; ++jj) { const int s = 16 * c.mt + 4 * c.quad + jj;
                    if (!(s < t)) { ab[e][jj] = 0.f; ak[e][jj] = 0.f; }
                    if (!(s <= t)) { rb[e][jj] = 0.f; rk[e][jj] = 0.f; } }
                storeT_bf(Ma, LQ, c, e, ab[e]);
                storeT_bf(Lak, LQ, c, e, ak[e]); storeT_bf(Lrb, LQ, c, e, rb[e]); storeT_bf(Lrk, LQ, c, e, rk[e]);
            }
        }
        if (tid < 224) {
            const int blk = tid >> 5, rr = (tid >> 1) & 15, hf = tid & 1;
            const int br = blk == 6 ? 1 : (blk < 3 ? 0 : (blk < 5 ? 1 : 2)), bc = blk == 6 ? 0 : (blk < 3 ? blk + 1 : (blk < 5 ? blk - 1 : 3));
            bf16_t* zp = (blk == 6 ? TmT : Tm) + (16 * br + rr) * LQ + 16 * bc + 8 * hf;
            *(u32x4*)zp = (u32x4){0u, 0u, 0u, 0u};
        }
        __syncthreads();
        if (wv == 0) {
            const int d = lane >> 4, cc = lane & 15; float tv[16];
#pragma unroll
            for (int rr = 0; rr < 16; ++rr) {
                const bf16_t* nr = Ma + (16 * d + rr) * LQ + 16 * d; const u32x4 q0 = *(const u32x4*)nr, q1 = *(const u32x4*)(nr + 8);
                const float nv[16] = {bflo(q0.x), bfhi(q0.x), bflo(q0.y), bfhi(q0.y), bflo(q0.z), bfhi(q0.z), bflo(q0.w), bfhi(q0.w), bflo(q1.x), bfhi(q1.x), bflo(q1.y), bfhi(q1.y), bflo(q1.z), bfhi(q1.z), bflo(q1.w), bfhi(q1.w)};
                float a = (rr == cc) ? 1.f : 0.f;
#pragma unroll
                for (int ss = 0; ss < rr; ++ss) a += nv[ss] * tv[ss];
                tv[rr] = a;
                Tm[(16 * d + rr) * LQ + 16 * d + cc] = f2bf(a);
            }
            bf16_t* tr = TmT + (16 * d + cc) * LQ + 16 * d;
            *(u32x4*)tr = (u32x4){pk2(tv[0], tv[1]), pk2(tv[2], tv[3]), pk2(tv[4], tv[5]), pk2(tv[6], tv[7])};
            *(u32x4*)(tr + 8) = (u32x4){pk2(tv[8], tv[9]), pk2(tv[10], tv[11]), pk2(tv[12], tv[13]), pk2(tv[14], tv[15])};
        }
        {
            f32x4 acc[2] = {z, z}; MM2(acc, Lak, LQ, Vt, 64);
#pragma unroll
            for (int e = 0; e < 2; ++e) storeT_bf(W2T, LQ, c, e, acc[e]);
        }
        __syncthreads();
        if (wv < 2) {
            const int lo = 32 * wv, hi = lo + 16;
            const f32x4 a = mm1<16>(z, Ma, hi, TmT, lo, lo, c.l16, c.quad);
            st1T(Zt, hi, lo, c.l16, c.quad, a);
        }
        __syncthreads();
        if (wv < 2) {
            const int lo = 32 * wv, hi = lo + 16;
            const f32x4 a = mm1<16>(z, Tm, hi, Zt, lo, hi, c.l16, c.quad);
            st1N(Tm, hi, lo, c.l16, c.quad, a); st1T(TmT, hi, lo, c.l16, c.quad, a);
        }
        __syncthreads();
        if (wv < 4) {
            const int tb = 32 + 16 * (wv >> 1), ub = 16 * (wv & 1);
            const f32x4 a = mm1<32>(z, Ma, tb, TmT, ub, 0, c.l16, c.quad);
            st1T(Zt, tb, ub, c.l16, c.quad, a);
        }
        __syncthreads();
        if (wv < 4) {
            const int tb = 32 + 16 * (wv >> 1), ub = 16 * (wv & 1);
            const f32x4 a = mm1<32>(z, Zt, ub, Tm, tb, 32, c.l16, c.quad);
            st1T(Tm, ub, tb, c.l16, c.quad, a);
        }
        __syncthreads();
        {
            f32x4 ap[2] = {z, z}, aq[2] = {z, z};
            MM2(ap, Tm, LQ, At, 64); MM2(aq, Tm, LQ, W2T, LQ);
#pragma unroll
            for (int e = 0; e < 2; ++e) { storeT_bf(PT, LQ, c, e, ap[e]); storeT_bf(QT, LQ, c, e, aq[e]); }
        }
        __syncthreads();
        {
            f32x4 ar[2] = {z, z}, ag[2] = {z, z}, ay[2] = {z, z}, ah[2] = {z, z};
            MM2(ar, PT, LQ, Lrb, LQ);
            MM2(ag, PT, LQ, Bt, 64);
            MM2(ay, Lrb, LQ, QT, LQ); MM2(ay, Lrk, LQ, Vt, 64);
            MM2(ah, Bt, 64, QT, LQ); MM2(ah, Kt, 64, Vt, 64);
#pragma unroll
            for (int e = 0; e < 2; ++e) {
                const int n = 16 * (c.nt0 + e) + c.l16, m0 = 16 * c.mt + 4 * c.quad; const size_t o = cb + (size_t)n * 64 + m0;
                const f32x4 rr = loadT_bf(Rn, 64, c, e) + ar[e];
                *(u32x2*)(P.cR + o) = (u32x2){pk2(rr[0], rr[1]), pk2(rr[2], rr[3])};
                const float gc = P.gC[(size_t)ci * 64 + n];
                f32x4 gg = ag[e];
#pragma unroll
                for (int jj = 0; jj < 4; ++jj) gg[jj] = gc * (gg[jj] + (m0 + jj == n ? 1.f : 0.f));
                *(u32x2*)(P.cG + o) = (u32x2){pk2(gg[0], gg[1]), pk2(gg[2], gg[3])};
                *(f32x4*)(P.cY + o) = ay[e];
                *(f32x4*)(P.cH + o) = ah[e] * *(const f32x4*)(P.gC + (size_t)ci * 64 + m0);
            }
        }
        __syncthreads();
    }
}

constexpr int FS_AWD = 12 * LMB * 2, FS_AAD = FS_AWD + LMB * 2, FS_WU = FS_AAD + LMB * 2, FS_AU = FS_WU + LMB * 2, FS_MISC = FS_AU + LMB * 2;
constexpr int FUSED_LDS = FS_MISC + 4096;
__device__ void phaseF(const Params& P, unsigned char* lds) {
    bf16_t* L0 = (bf16_t*)lds;
    bf16_t *sAn = L0, *sBn = L0 + LMB, *sKn = L0 + 2 * LMB, *sRn = L0 + 3 * LMB, *sAt = L0 + 4 * LMB, *sBt = L0 + 5 * LMB, *sKt = L0 + 6 * LMB, *sVt = L0 + 7 * LMB;
    bf16_t *Ma = L0 + 8 * LMB, *Lak = L0 + 9 * LMB, *Lrb = L0 + 10 * LMB, *Lrk = L0 + 11 * LMB;
    bf16_t *Tm = sAn, *TmT = sBn, *W2T = sKn, *Zt = Lak, *PT = Ma, *QT = sBn;
    float* LW = (float*)(L0 + 8 * LMB);
    float* XK = (float*)(L0 + 10 * LMB);
    bf16_t* Awd = (bf16_t*)(lds + FS_AWD); bf16_t* Aad = (bf16_t*)(lds + FS_AAD); bf16_t* WU = (bf16_t*)(lds + FS_WU); bf16_t* AU = (bf16_t*)(lds + FS_AU);
    float* ssn = (float*)(lds + FS_MISC);
    float* BP = ssn + 64;
    float* gCl = BP + 128;
    float* SEG = gCl + 64;
    const int tid = threadIdx.x, wv = tid >> 6, lane = tid & 63;
    TileCtx c; c.mt = wv >> 1; c.nt0 = (wv & 1) * 2; c.l16 = lane & 15; c.quad = lane >> 4;
    const f32x4 z = {0.f, 0.f, 0.f, 0.f};
    float* MU = (float*)(lds + FS_MISC + 4096);
    for (int i = tid; i < 2176; i += 512) MU[i] = P.mu_b[i];
    for (int grp = blockIdx.x; grp < 512; grp += gridDim.x) {
        const unsigned m0 = (unsigned)grp * 64u;
        {
            const int t = tid >> 3, c16 = (tid & 7) * 16; const unsigned row = m0 + t;
            const bf16_t* q = P.p + (size_t)row * NP + CB0 + CB_WD + c16; const bool hasprev = (row & 4095u) != 0;
            const u32x4 zz = {0u, 0u, 0u, 0u};
            const u32x4 c0 = *(const u32x4*)q, c1 = *(const u32x4*)(q + 8);
            const u32x4 p0 = hasprev ? *(const u32x4*)(q - NP) : zz, p1 = hasprev ? *(const u32x4*)(q - NP + 8) : zz;
            const unsigned cw[8] = {c0.x, c0.y, c0.z, c0.w, c1.x, c1.y, c1.z, c1.w}, pw[8] = {p0.x, p0.y, p0.z, p0.w, p1.x, p1.y, p1.z, p1.w};
            unsigned ow[8];
#pragma unroll
            for (int j = 0; j < 8; ++j) {
                const float m_lo = P.mu_b[CB_WD + c16 + 2 * j], m_hi = P.mu_b[CB_WD + c16 + 2 * j + 1];
                float lo = bflo(cw[j]), hi = bfhi(cw[j]);
                lo += m_lo * (bflo(pw[j]) - lo); hi += m_hi * (bfhi(pw[j]) - hi);
                if (c16 < 64) { lo = 1.f - 2.f * rcpf_(1.f + __expf(2.f * lo)); hi = 1.f - 2.f * rcpf_(1.f + __expf(2.f * hi)); }
                ow[j] = pk2(lo, hi);
            }
            bf16_t* dst = (c16 < 64) ? (Awd + t * LQ + c16) : (Aad + t * LQ + (c16 - 64));
            *(u32x4*)dst = (u32x4){ow[0], ow[1], ow[2], ow[3]}; *(u32x4*)(dst + 8) = (u32x4){ow[4], ow[5], ow[6], ow[7]};
        }
        u32x4 gc_[4], gp_[4], gw_, ga_;
        auto gloadA = [&](int hd_) {
            const int t = tid >> 3, c8 = (tid & 7) * 8, n = hd_ * 64 + c8; const unsigned row = m0 + t; const bool hasprev = (row & 4095u) != 0;
            const bf16_t* pr = P.p + (size_t)row * NP + CB0 + n;
#pragma unroll
            for (int qn = 0; qn < 4; ++qn) { gc_[qn] = *(const u32x4*)(pr + 512 * qn); gp_[qn] = (u32x4){0u, 0u, 0u, 0u}; if (hasprev) gp_[qn] = *(const u32x4*)(pr + 512 * qn - NP); }
            gw_ = *(const u32x4*)(P.wupT + (size_t)(hd_ * 64 + t) * 64 + c8); ga_ = *(const u32x4*)(P.aupT + (size_t)(hd_ * 64 + t) * 64 + c8);
        };
        gloadA(0);
        LBAR();
#pragma unroll 1
        for (int hd = 0; hd < 8; ++hd) {
            int tidl = tid; asm volatile("" : "+v"(tidl));
            const int lanel = tidl & 63; c.l16 = lanel & 15; c.quad = lanel >> 4;
            const int ci = ((grp >> 6) * 8 + hd) * 64 + (grp & 63);
            const size_t cb = (size_t)ci * 4096;
            float w0n[2], a0n[2], kkn[2], kan[2], rkn[2];
#pragma unroll
            for (int e = 0; e < 2; ++e) { const int n = hd * 64 + 16 * (c.nt0 + e) + c.l16; w0n[e] = P.w0[n]; a0n[e] = P.a0[n]; kkn[e] = P.k_k[n]; kan[e] = P.k_a[n]; rkn[e] = P.r_k[n]; }
            {
                const int t = tidl >> 3, c8 = (tidl & 7) * 8, n = hd * 64 + c8; const unsigned row = m0 + t;
                float xr[8], xk[8], xv[8], xg[8];
#define XS8(dst, CBQ, cu, pv) do { const f32x4 mA = *(const f32x4*)(MU + (CBQ) + n), mB = *(const f32x4*)(MU + (CBQ) + n + 4); \
                    const unsigned cw_[4] = {cu.x, cu.y, cu.z, cu.w}, pw_[4] = {pv.x, pv.y, pv.z, pv.w}; \
                    _Pragma("unroll") for (int j_ = 0; j_ < 4; ++j_) { const float l_ = bflo(cw_[j_]), h_ = bfhi(cw_[j_]); const float ml_ = j_ < 2 ? mA[2 * j_] : mB[2 * j_ - 4], mh_ = j_ < 2 ? mA[2 * j_ + 1] : mB[2 * j_ - 3]; \
                        dst[2 * j_] = l_ + ml_ * (bflo(pw_[j_]) - l_); dst[2 * j_ + 1] = h_ + mh_ * (bfhi(pw_[j_]) - h_); } } while (0)
                XS8(xr, CB_R, gc_[0], gp_[0]); XS8(xk, CB_K, gc_[1], gp_[1]); XS8(xv, CB_V, gc_[2], gp_[2]); XS8(xg, CB_G, gc_[3], gp_[3]);
#undef XS8
                *(u32x4*)(sRn + t * LQ + c8) = (u32x4){pk2(xr[0], xr[1]), pk2(xr[2], xr[3]), pk2(xr[4], xr[5]), pk2(xr[6], xr[7])};
                const f32x4 kA = *(const f32x4*)(P.k_k + n), kB = *(const f32x4*)(P.k_k + n + 4);
                float s = 0.f;
#pragma unroll
                for (int j = 0; j < 8; ++j) { XK[t * 65 + c8 + j] = xk[j]; const float kk = xk[j] * (j < 4 ? kA[j & 3] : kB[j & 3]); s += kk * kk; }
                s += dppf<0xB1>(s); s += dppf<0x4E>(s); s += dppf<0x141>(s);
                if ((tidl & 7) == 0) ssn[t] = rsqrtf(s + 1e-12f);
                const size_t fo = cb + (size_t)((((t >> 4) * 64 + ((c8 >> 2) & 3) * 16 + (t & 15)) * 4 + (c8 >> 4)) * 4);
                *(u32x2*)(P.sv + fo) = (u32x2){pk2(xv[0], xv[1]), pk2(xv[2], xv[3])}; *(u32x2*)(P.sv + fo + 256) = (u32x2){pk2(xv[4], xv[5]), pk2(xv[6], xv[7])};
#pragma unroll
                for (int j = 0; j < 8; ++j) { sVt[(c8 + j) * LQ + t] = f2bf(xv[j]); xg[j] = silu(xg[j]); }
                *(u32x2*)(P.sg + fo) = (u32x2){pk2(xg[0], xg[1]), pk2(xg[2], xg[3])}; *(u32x2*)(P.sg + fo + 256) = (u32x2){pk2(xg[4], xg[5]), pk2(xg[6], xg[7])};
                __builtin_amdgcn_sched_barrier(0);
                *(u32x4*)(WU + t * LQ + c8) = gw_; *(u32x4*)(AU + t * LQ + c8) = ga_;
                __builtin_amdgcn_sched_barrier(0);
                if (hd + 1 < 8) gloadA(hd + 1);
            }
            LBAR();
            f32x4 aw[2] = {z, z}, aa[2] = {z, z};
            MM2(aw, Awd, LQ, WU, LQ); MM2(aa, Aad, LQ, AU, LQ);
            f32x4 cum[2];
#pragma unroll
            for (int e = 0; e < 2; ++e) {
#pragma unroll
                for (int jj = 0; jj < 4; ++jj) aw[e][jj] = -0.60653066f * sigm(w0n[e] + aw[e][jj]);
                const float p0 = aw[e][0], p1 = p0 + aw[e][1], p2 = p1 + aw[e][2], p3 = p2 + aw[e][3];
                float x = p3;
                { const float y = __shfl_up(x, 16); if (c.quad >= 1) x += y; }
                { const float y = __shfl_up(x, 32); if (c.quad >= 2) x += y; }
                const float ex = x - p3;
                if (c.quad == 3) SEG[c.mt * 64 + 16 * (c.nt0 + e) + c.l16] = x;
                cum[e] = (f32x4){ex + p0, ex + p1, ex + p2, ex + p3};
            }
            LBAR();
#pragma unroll
            for (int e = 0; e < 2; ++e) {
                const int n = 16 * (c.nt0 + e) + c.l16;
                const float t0 = SEG[n], t1 = SEG[64 + n], t2 = SEG[128 + n], t3 = SEG[192 + n];
                const float off = (c.mt > 0 ? t0 : 0.f) + (c.mt > 1 ? t1 : 0.f) + (c.mt > 2 ? t2 : 0.f);
                cum[e] = cum[e] + off;
                if (c.mt == 0 && c.quad == 0) gCl[n] = __expf(t0 + t1 + t2 + t3);
            }
            {
                float bp[4] = {0.f, 0.f, 0.f, 0.f};
#pragma unroll
                for (int e = 0; e < 2; ++e) {
                    const int n = 16 * (c.nt0 + e) + c.l16;
                    float tA[4], tB[4], tK[4];
#pragma unroll
                    for (int jj = 0; jj < 4; ++jj) {
                        const int t = 16 * c.mt + 4 * c.quad + jj;
                        const float ec = cum[e][jj], lw = aw[e][jj], a = sigm(a0n[e] + aa[e][jj]), xk = XK[t * 65 + n], xr = bf2f(sRn[t * LQ + n]);
                        const float e1 = __expf(ec), gi = rcpf_(e1);
                        const float kk = xk * kkn[e] * ssn[t], kp = xk * (1.f + (a - 1.f) * kan[e]), bq = kk * a;
                        tA[jj] = -kk * __expf(ec - lw); tB[jj] = bq * gi; tK[jj] = kp * gi;
                        sAn[t * LQ + n] = f2bf(tA[jj]); sBn[t * LQ + n] = f2bf(tB[jj]); sKn[t * LQ + n] = f2bf(tK[jj]); sRn[t * LQ + n] = f2bf(xr * e1);
                        bp[jj] += xr * kp * rkn[e];
                    }
                    const int ot = n * LQ + 16 * c.mt + 4 * c.quad;
                    *(u32x2*)(sAt + ot) = (u32x2){pk2(tA[0], tA[1]), pk2(tA[2], tA[3])};
                    *(u32x2*)(sBt + ot) = (u32x2){pk2(tB[0], tB[1]), pk2(tB[2], tB[3])};
                    *(u32x2*)(sKt + ot) = (u32x2){pk2(tK[0], tK[1]), pk2(tK[2], tK[3])};
                }
#pragma unroll
                for (int jj = 0; jj < 4; ++jj) { const float s = reduce16(bp[jj]); if (c.l16 == 0) BP[(16 * c.mt + 4 * c.quad + jj) * 2 + (wv & 1)] = s; }
            }
            LBAR();
            if (tidl < 64) P.bonus[(size_t)(m0 + tidl) * 8 + hd] = BP[tidl * 2] + BP[tidl * 2 + 1];
            {
                f32x4 ab[2] = {z, z}, ak[2] = {z, z}, rb[2] = {z, z}, rk[2] = {z, z};
                MM2(ab, sBn, LQ, sAn, LQ); MM2(ak, sKn, LQ, sAn, LQ); MM2(rb, sBn, LQ, sRn, LQ); MM2(rk, sKn, LQ, sRn, LQ);
#pragma unroll
                for (int e = 0; e < 2; ++e) {
                    const int t = 16 * (c.nt0 + e) + c.l16;
#pragma unroll
                    for (int jj = 0; jj < 4; ++jj) { const int s = 16 * c.mt + 4 * c.quad + jj;
                        if (!(s < t)) { ab[e][jj] = 0.f; ak[e][jj] = 0.f; }
                        if (!(s <= t)) { rb[e][jj] = 0.f; rk[e][jj] = 0.f; } }
                    storeT_bf(Ma, LQ, c, e, ab[e]); storeT_bf(Lak, LQ, c, e, ak[e]); storeT_bf(Lrb, LQ, c, e, rb[e]); storeT_bf(Lrk, LQ, c, e, rk[e]);
                }
            }
            LBAR();
            if (tidl < 224) {
                const int blk = tidl >> 5, rr = (tidl >> 1) & 15, hf = tidl & 1;
                const int br = blk == 6 ? 1 : (blk < 3 ? 0 : (blk < 5 ? 1 : 2)), bc = blk == 6 ? 0 : (blk < 3 ? blk + 1 : (blk < 5 ? blk - 1 : 3));
                bf16_t* zp = (blk == 6 ? TmT : Tm) + (16 * br + rr) * LQ + 16 * bc + 8 * hf;
                *(u32x4*)zp = (u32x4){0u, 0u, 0u, 0u};
            }
            if (wv == 0) {
                __builtin_amdgcn_s_setprio(3);
                const int d = lanel >> 4, cc = lanel & 15; float tv[16];
#pragma unroll
                for (int rr = 0; rr < 16; ++rr) {
                    const bf16_t* nr = Ma + (16 * d + rr) * LQ + 16 * d; const u32x4 q0 = *(const u32x4*)nr, q1 = *(const u32x4*)(nr + 8);
                    const float nv[16] = {bflo(q0.x), bfhi(q0.x), bflo(q0.y), bfhi(q0.y), bflo(q0.z), bfhi(q0.z), bflo(q0.w), bfhi(q0.w), bflo(q1.x), bfhi(q1.x), bflo(q1.y), bfhi(q1.y), bflo(q1.z), bfhi(q1.z), bflo(q1.w), bfhi(q1.w)};
                    float a = (rr == cc) ? 1.f : 0.f;
#pragma unroll
                    for (int ss = 0; ss < rr; ++ss) a += nv[ss] * tv[ss];
                    tv[rr] = a;
                    Tm[(16 * d + rr) * LQ + 16 * d + cc] = f2bf(a);
                }
                bf16_t* tr = TmT + (16 * d + cc) * LQ + 16 * d;
                *(u32x4*)tr = (u32x4){pk2(tv[0], tv[1]), pk2(tv[2], tv[3]), pk2(tv[4], tv[5]), pk2(tv[6], tv[7])};
                *(u32x4*)(tr + 8) = (u32x4){pk2(tv[8], tv[9]), pk2(tv[10], tv[11]), pk2(tv[12], tv[13]), pk2(tv[14], tv[15])};
                __builtin_amdgcn_s_setprio(0);
            }
            {
                f32x4 acc[2] = {z, z}; MM2(acc, Lak, LQ, sVt, LQ);
#pragma unroll
                for (int e = 0; e < 2; ++e) storeT_bf(W2T, LQ, c, e, acc[e]);
            }
            LBAR();
            if (wv < 2) {
                const int lo = 32 * wv, hi = lo + 16;
                const f32x4 a = mm1<16>(z, Ma, hi, TmT, lo, lo, c.l16, c.quad); st1T(Zt, hi, lo, c.l16, c.quad, a);
                const f32x4 b = mm1<16>(z, Tm, hi, Zt, lo, hi, c.l16, c.quad); st1N(Tm, hi, lo, c.l16, c.quad, b); st1T(TmT, hi, lo, c.l16, c.quad, b);
            }
            LBAR();
            if (wv < 2) {
                const int ub = 16 * wv;
                const f32x4 a0 = mm1<32>(z, Ma, 32, TmT, ub, 0, c.l16, c.quad), a1 = mm1<32>(z, Ma, 48, TmT, ub, 0, c.l16, c.quad);
                st1T(Zt, 32, ub, c.l16, c.quad, a0); st1T(Zt, 48, ub, c.l16, c.quad, a1);
                const f32x4 b0 = mm1<32>(z, Zt, ub, Tm, 32, 32, c.l16, c.quad), b1 = mm1<32>(z, Zt, ub, Tm, 48, 32, c.l16, c.quad);
                st1T(Tm, ub, 32, c.l16, c.quad, b0); st1T(Tm, ub, 48, c.l16, c.quad, b1);
            }
            LBAR();
            {
                f32x4 ap[2] = {z, z}, aq[2] = {z, z};
                MM2(ap, Tm, LQ, sAt, LQ); MM2(aq, Tm, LQ, W2T, LQ);
#pragma unroll
                for (int e = 0; e < 2; ++e) { storeT_bf(PT, LQ, c, e, ap[e]); storeT_bf(QT, LQ, c, e, aq[e]); }
            }
            LBAR();
            {
                f32x4 ar[2] = {z, z}, ag[2] = {z, z};
                MM2(ar, PT, LQ, Lrb, LQ);
                MM2(ag, PT, LQ, sBt, LQ);
#pragma unroll
                for (int e = 0; e < 2; ++e) {
                    const int n = 16 * (c.nt0 + e) + c.l16, mm0 = 16 * c.mt + 4 * c.quad; const size_t o = cb + (size_t)n * 64 + mm0;
                    const f32x4 rr = loadT_bf(sRn, LQ, c, e) + ar[e];
                    *(u32x2*)(P.cR + cb + (size_t)(((((c.nt0 + e) * 2 + (c.mt >> 1)) * 64 + c.quad * 16 + c.l16) * 2 + (c.mt & 1)) * 4)) = (u32x2){pk2(rr[0], rr[1]), pk2(rr[2], rr[3])};
                    const float gc = gCl[n];
                    f32x4 gg = ag[e];
#pragma unroll
                    for (int jj = 0; jj < 4; ++jj) gg[jj] = gc * (gg[jj] + (mm0 + jj == n ? 1.f : 0.f));
                    *(u32x2*)(P.cG + cb + (size_t)(((((c.nt0 + e) * 2 + (c.mt >> 1)) * 64 + c.quad * 16 + c.l16) * 2 + (c.mt & 1)) * 4)) = (u32x2){pk2(gg[0], gg[1]), pk2(gg[2], gg[3])};
                }
            }
            __builtin_amdgcn_sched_barrier(0);
            {
                f32x4 ay[2] = {z, z}, ah[2] = {z, z};
                MM2(ay, QT, LQ, Lrb, LQ); MM2(ay, sVt, LQ, Lrk, LQ);
                MM2(ah, sBt, LQ, QT, LQ); MM2(ah, sKt, LQ, sVt, LQ);
#pragma unroll
                for (int e = 0; e < 2; ++e) {
                    const int n = 16 * (c.nt0 + e) + c.l16, mm0 = 16 * c.mt + 4 * c.quad; const size_t o = cb + (size_t)n * 64 + mm0;
                    const size_t of = cb + (size_t)((((c.nt0 + e) * 64 + c.quad * 16 + c.l16) * 4 + c.mt) * 4);
                    *(u32x2*)(P.cY + of) = (u32x2){pk2(ay[e][0], ay[e][1]), pk2(ay[e][2], ay[e][3])};
                    const f32x4 hh = ah[e] * *(const f32x4*)(gCl + mm0);
                    *(u32x2*)(P.cH + of) = (u32x2){pk2(hh[0], hh[1]), pk2(hh[2], hh[3])};
                }
            }
            LBAR();
        }
    }
}

__device__ void phase4b(const Params& P) {
    const int tid = threadIdx.x, wv = tid >> 6, lane = tid & 63, l16 = lane & 15, quad = lane >> 4;
    for (int item = wv * (int)gridDim.x + (int)blockIdx.x; item < 256; item += 8 * (int)gridDim.x) {
        const int bh = item >> 2, ig = item & 3, b = bh >> 3, hd = bh & 7;
        f32x4 S[4];
#pragma unroll
        for (int mt = 0; mt < 4; ++mt) S[mt] = (f32x4){0.f, 0.f, 0.f, 0.f};
        u32x2 gG[4][2][2], gR[4][2][2]; f32x4 gH[4], gY[4];
        auto gload = [&](int cidx) {
            const size_t cb = ((size_t)bh * 64 + cidx) * 4096;
#pragma unroll
            for (int mt = 0; mt < 4; ++mt) {
#pragma unroll
                for (int ks = 0; ks < 2; ++ks)
#pragma unroll
                    for (int hf = 0; hf < 2; ++hf) {
                        gG[mt][ks][hf] = *(const u32x2*)(P.cG + cb + (size_t)(16 * mt + l16) * 64 + 32 * ks + 16 * hf + 4 * quad);
                        gR[mt][ks][hf] = *(const u32x2*)(P.cR + cb + (size_t)(16 * mt + l16) * 64 + 32 * ks + 16 * hf + 4 * quad);
                    }
                gH[mt] = *(const f32x4*)(P.cH + cb + (size_t)(16 * ig + l16) * 64 + 16 * mt + 4 * quad);
                gY[mt] = *(const f32x4*)(P.cY + cb + (size_t)(16 * ig + l16) * 64 + 16 * mt + 4 * quad);
            }
        };
        gload(0);
        for (int cidx = 0; cidx < 64; ++cidx) {
            bf16x8 bhi[2], blo[2];
#pragma unroll
            for (int ks = 0; ks < 2; ++ks) {
                u32x4 wh, wl;
#pragma unroll
                for (int hf = 0; hf < 2; ++hf) {
                    const f32x4 v = S[2 * ks + hf];
                    const unsigned h0 = pk2(v[0], v[1]), h1 = pk2(v[2], v[3]);
                    const unsigned l0 = pk2(v[0] - bflo(h0), v[1] - bfhi(h0)), l1 = pk2(v[2] - bflo(h1), v[3] - bfhi(h1));
                    if (hf == 0) { wh.x = h0; wh.y = h1; wl.x = l0; wl.y = l1; } else { wh.z = h0; wh.w = h1; wl.z = l0; wl.w = l1; }
                }
                bhi[ks] = __builtin_bit_cast(bf16x8, wh); blo[ks] = __builtin_bit_cast(bf16x8, wl);
            }
            f32x4 Y[4], Sn[4];
#pragma unroll
            for (int mt = 0; mt < 4; ++mt) {
                Y[mt] = gY[mt]; Sn[mt] = gH[mt];
#pragma unroll
                for (int ks = 0; ks < 2; ++ks) {
                    const bf16x8 ar = __builtin_bit_cast(bf16x8, (u32x4){gR[mt][ks][0].x, gR[mt][ks][0].y, gR[mt][ks][1].x, gR[mt][ks][1].y});
                    const bf16x8 ag = __builtin_bit_cast(bf16x8, (u32x4){gG[mt][ks][0].x, gG[mt][ks][0].y, gG[mt][ks][1].x, gG[mt][ks][1].y});
                    Y[mt] = mfma16(ar, bhi[ks], Y[mt]); Y[mt] = mfma16(ar, blo[ks], Y[mt]);
                    Sn[mt] = mfma16(ag, bhi[ks], Sn[mt]); Sn[mt] = mfma16(ag, blo[ks], Sn[mt]);
                }
            }
            if (cidx + 1 < 64) gload(cidx + 1);
            const size_t rowb = (size_t)b * T + (size_t)cidx * 64;
#pragma unroll
            for (int mt = 0; mt < 4; ++mt) {
#pragma unroll
                for (int jj = 0; jj < 4; ++jj) P.y[(rowb + 16 * mt + 4 * quad + jj) * 512 + hd * 64 + 16 * ig + l16] = Y[mt][jj];
                S[mt] = Sn[mt];
            }
        }
    }
}

__device__ void phase5(const Params& P) {
    const int tid = threadIdx.x, tl = tid >> 7, hd = (tid >> 4) & 7, l16 = tid & 15, n = hd * 64 + l16 * 4;
    for (int it = blockIdx.x; it < MTOK / 4; it += gridDim.x) {
        const size_t row = (size_t)it * 4 + tl, o = row * 512 + n;
        const f32x4 yv = *(const f32x4*)(P.y + o);
        float s = yv[0] + yv[1] + yv[2] + yv[3]; s = reduce16(s);
        const float mean = s * (1.f / 64.f);
        const f32x4 dv = yv - mean;
        float q = dv[0] * dv[0] + dv[1] * dv[1] + dv[2] * dv[2] + dv[3] * dv[3]; q = reduce16(q);
        const float rstd = rsqrtf(q * (1.f / 64.f) + GN_EPS);
        const u32x2 vv = *(const u32x2*)(P.sv + o), gg = *(const u32x2*)(P.sg + o);
        const float v4[4] = {bflo(vv.x), bfhi(vv.x), bflo(vv.y), bfhi(vv.y)}, g4[4] = {bflo(gg.x), bfhi(gg.x), bflo(gg.y), bfhi(gg.y)};
        const float bs = P.bonus[row * 8 + hd];
        float ov[4];
#pragma unroll
        for (int j = 0; j < 4; ++j) ov[j] = (dv[j] * rstd * P.gn_g[n + j] + P.gn_b[n + j] + bs * v4[j]) * g4[j];
        *(u32x2*)(P.hbf + row * D + 512 + n) = (u32x2){pk2(ov[0], ov[1]), pk2(ov[2], ov[3])};
    }
}


__device__ void phase4s(const Params& P) {
    const int tid = threadIdx.x, wv = tid >> 6, lane = tid & 63, l16 = lane & 15, quad = lane >> 4;
    for (int item = wv * (int)gridDim.x + (int)blockIdx.x; item < 256; item += 8 * (int)gridDim.x) {
        const int bh = item >> 2, ig = item & 3;
        f32x4 S[4];
#pragma unroll
        for (int mt = 0; mt < 4; ++mt) S[mt] = (f32x4){0.f, 0.f, 0.f, 0.f};
        u32x4 gG[4][8]; u32x2 gH[4][4];
#define G4LOAD(u, cidx) do { const size_t cb_ = ((size_t)bh * 64 + (cidx)) * 4096; \
            _Pragma("unroll") for (int f_ = 0; f_ < 8; ++f_) gG[u][f_] = *(const u32x4*)(P.cG + cb_ + (size_t)(f_ * 64 + lane) * 8); \
            { const u32x4 h0_ = *(const u32x4*)(P.cH + cb_ + (size_t)(ig * 64 + lane) * 16), h1_ = *(const u32x4*)(P.cH + cb_ + (size_t)(ig * 64 + lane) * 16 + 8); \
              gH[u][0] = (u32x2){h0_.x, h0_.y}; gH[u][1] = (u32x2){h0_.z, h0_.w}; gH[u][2] = (u32x2){h1_.x, h1_.y}; gH[u][3] = (u32x2){h1_.z, h1_.w}; } } while (0)
        G4LOAD(0, 0); G4LOAD(1, 1); G4LOAD(2, 2);
#pragma unroll 1
        for (int c0 = 0; c0 < 64; c0 += 4) {
#pragma unroll
            for (int u = 0; u < 4; ++u) {
                const int cidx = c0 + u;
                { const int nc = cidx + 3 < 64 ? cidx + 3 : 63; G4LOAD((u + 3) & 3, nc); }
                __builtin_amdgcn_sched_barrier(0);
                const size_t cb = ((size_t)bh * 64 + cidx) * 4096;
                bf16x8 bhi[2], blo[2];
#pragma unroll
                for (int ks = 0; ks < 2; ++ks) {
                    u32x4 wh, wl;
#pragma unroll
                    for (int hf = 0; hf < 2; ++hf) {
                        const f32x4 v = S[2 * ks + hf];
                        const unsigned h0 = pk2(v[0], v[1]), h1 = pk2(v[2], v[3]);
                        const unsigned l0 = pk2(v[0] - bflo(h0), v[1] - bfhi(h0)), l1 = pk2(v[2] - bflo(h1), v[3] - bfhi(h1));
                        if (hf == 0) { wh.x = h0; wh.y = h1; wl.x = l0; wl.y = l1; } else { wh.z = h0; wh.w = h1; wl.z = l0; wl.w = l1; }
                    }
                    bhi[ks] = __builtin_bit_cast(bf16x8, wh); blo[ks] = __builtin_bit_cast(bf16x8, wl);
                    *(u32x4*)(P.cS + cb + (size_t)((ig * 2 + ks) * 64 + lane) * 8) = wh;
                }
#pragma unroll
                for (int mt = 0; mt < 4; ++mt) {
                    f32x4 sn = {bflo(gH[u][mt].x), bfhi(gH[u][mt].x), bflo(gH[u][mt].y), bfhi(gH[u][mt].y)};
#pragma unroll
                    for (int ks = 0; ks < 2; ++ks) { const bf16x8 ag = __builtin_bit_cast(bf16x8, gG[u][mt * 2 + ks]); sn = mfma16(ag, bhi[ks], sn); sn = mfma16(ag, blo[ks], sn); }
                    S[mt] = sn;
                }
            }
        }
#undef G4LOAD
    }
}

__device__ void phase5y(const Params& P) {
    const int tid = threadIdx.x, wv = tid >> 6, lane = tid & 63, l16 = lane & 15, quad = lane >> 4;
    for (int ci = (int)blockIdx.x * 8 + wv; ci < 4096; ci += 8 * (int)gridDim.x) {
        const size_t cb = (size_t)ci * 4096;
        const int bh = ci >> 6, cidx = ci & 63, b = bh >> 3, hd = bh & 7;
        bf16x8 as[4][2];
#pragma unroll
        for (int mt = 0; mt < 4; ++mt)
#pragma unroll
            for (int ks = 0; ks < 2; ++ks) as[mt][ks] = *(const bf16x8*)(P.cS + cb + (size_t)((mt * 2 + ks) * 64 + lane) * 8);
#pragma unroll 1
        for (int half = 0; half < 2; ++half) {
            f32x4 acc[2][4]; bf16x8 br[2][2]; u32x2 vv[2][4], gg[2][4]; float bs[2]; size_t rowv[2];
#pragma unroll
            for (int u = 0; u < 2; ++u) {
                const int t = 16 * (2 * half + u) + l16;
                rowv[u] = (size_t)b * T + (size_t)cidx * 64 + t;
#pragma unroll
                for (int mt = 0; mt < 4; ++mt) {
                    { const u32x2 yq = *(const u32x2*)(P.cY + cb + (size_t)(((2 * half + u) * 64 + lane) * 4 + mt) * 4); acc[u][mt] = (f32x4){bflo(yq.x), bfhi(yq.x), bflo(yq.y), bfhi(yq.y)}; }
                    const int n = hd * 64 + 16 * mt + 4 * quad;
                    vv[u][mt] = *(const u32x2*)(P.sv + cb + (size_t)(((2 * half + u) * 64 + lane) * 4 + mt) * 4); gg[u][mt] = *(const u32x2*)(P.sg + cb + (size_t)(((2 * half + u) * 64 + lane) * 4 + mt) * 4);
                }
#pragma unroll
                for (int ks = 0; ks < 2; ++ks) br[u][ks] = *(const bf16x8*)(P.cR + cb + (size_t)(((2 * half + u) * 2 + ks) * 64 + lane) * 8);
                bs[u] = P.bonus[rowv[u] * 8 + hd];
            }
#pragma unroll
            for (int u = 0; u < 2; ++u) {
#pragma unroll
                for (int ks = 0; ks < 2; ++ks)
#pragma unroll
                    for (int mt = 0; mt < 4; ++mt) acc[u][mt] = mfma16(as[mt][ks], br[u][ks], acc[u][mt]);
                float s = 0.f;
#pragma unroll
                for (int mt = 0; mt < 4; ++mt) s += acc[u][mt][0] + acc[u][mt][1] + acc[u][mt][2] + acc[u][mt][3];
                s += __shfl_xor(s, 16); s += __shfl_xor(s, 32);
                const float mean = s * (1.f / 64.f);
                float q = 0.f;
#pragma unroll
                for (int mt = 0; mt < 4; ++mt) { acc[u][mt] = acc[u][mt] - mean; q += acc[u][mt][0] * acc[u][mt][0] + acc[u][mt][1] * acc[u][mt][1] + acc[u][mt][2] * acc[u][mt][2] + acc[u][mt][3] * acc[u][mt][3]; }
                q += __shfl_xor(q, 16); q += __shfl_xor(q, 32);
                const float rstd = rsqrtf(q * (1.f / 64.f) + GN_EPS);
#pragma unroll
                for (int mt = 0; mt < 4; ++mt) {
                    const int n = hd * 64 + 16 * mt + 4 * quad;
                    const f32x4 g = *(const f32x4*)(P.gn_g + n), be = *(const f32x4*)(P.gn_b + n);
                    const f32x4 v4 = {bflo(vv[u][mt].x), bfhi(vv[u][mt].x), bflo(vv[u][mt].y), bfhi(vv[u][mt].y)}, g4 = {bflo(gg[u][mt].x), bfhi(gg[u][mt].x), bflo(gg[u][mt].y), bfhi(gg[u][mt].y)};
                    const f32x4 o = (acc[u][mt] * rstd * g + be + bs[u] * v4) * g4;
                    *(u32x2*)(P.hbf + rowv[u] * D + 512 + n) = (u32x2){pk2(o[0], o[1]), pk2(o[2], o[3])};
                }
            }
        }
    }
}

struct EpiOut {
    static constexpr bool PERM = true, AFTER_DRAIN = false;
    bf16_t* C; const float* mod;
    __device__ __forceinline__ void operator()(const pg8::f32x4 (&acc)[2][2][4][2], const pg8::Unit& u, int wr, int wc, int fr, int fq) const {
        const int row0 = u.pm * 256 + wr * 64 + fr, col0 = u.pn * 256 + wc * 32 + 8 * fq, b = (u.pm * 256) >> 12;
        pg8::f32x4 gv[2][2];
#pragma unroll
        for (int bj = 0; bj < 2; ++bj)
#pragma unroll
            for (int n = 0; n < 2; ++n) gv[bj][n] = *(const pg8::f32x4*)(mod + b * 3072 + 2048 + col0 + bj * 128 + 4 * n);
#pragma unroll
        for (int ai = 0; ai < 2; ++ai)
#pragma unroll
            for (int m = 0; m < 4; ++m) { const size_t ro = (size_t)(row0 + ai * 128 + m * 16) * 1024 + col0;
#pragma unroll
                for (int bj = 0; bj < 2; ++bj) {
                    const pg8::f32x4 v0 = gv[bj][0] * acc[ai][bj][m][0], v1 = gv[bj][1] * acc[ai][bj][m][1];
                    *(u32x4*)(C + ro + bj * 128) = (u32x4){pk2(v0[0], v0[1]), pk2(v0[2], v0[3]), pk2(v1[0], v1[1]), pk2(v1[2], v1[3])}; } }
    }
};

__device__ void phase7(const Params& P) {
    const int wv = threadIdx.x >> 6, lane = threadIdx.x & 63;
    f32x4 g4[4], b4[4];
#pragma unroll
    for (int q = 0; q < 4; ++q) { g4[q] = *(const f32x4*)(P.ln_g + (q >> 1) * 512 + lane * 8 + (q & 1) * 4); b4[q] = *(const f32x4*)(P.ln_b + (q >> 1) * 512 + lane * 8 + (q & 1) * 4); }
    for (int it = blockIdx.x; it < MTOK / 8; it += gridDim.x) {
        const size_t row = (size_t)it * 8 + wv;
        const bf16_t* sp = P.pre + row * D + lane * 8;
        const u32x4 w0 = *(const u32x4*)sp, w1 = *(const u32x4*)(sp + 512);
        f32x4 v[4] = {{bflo(w0.x), bfhi(w0.x), bflo(w0.y), bfhi(w0.y)}, {bflo(w0.z), bfhi(w0.z), bflo(w0.w), bfhi(w0.w)}, {bflo(w1.x), bfhi(w1.x), bflo(w1.y), bfhi(w1.y)}, {bflo(w1.z), bfhi(w1.z), bflo(w1.w), bfhi(w1.w)}};
        { const float* xp = P.x + row * D + lane * 8;
#pragma unroll
          for (int q = 0; q < 4; ++q) v[q] = v[q] + ALPHA * *(const f32x4*)(xp + (q >> 1) * 512 + (q & 1) * 4); }
        float s = 0.f;
#pragma unroll
        for (int q = 0; q < 4; ++q) s += v[q][0] + v[q][1] + v[q][2] + v[q][3];
#pragma unroll
        for (int o = 32; o > 0; o >>= 1) s += __shfl_xor(s, o);
        const float mean = s * (1.f / 1024.f);
        float qq = 0.f;
#pragma unroll
        for (int q = 0; q < 4; ++q) { v[q] = v[q] - mean; qq += v[q][0] * v[q][0] + v[q][1] * v[q][1] + v[q][2] * v[q][2] + v[q][3] * v[q][3]; }
#pragma unroll
        for (int o = 32; o > 0; o >>= 1) qq += __shfl_xor(qq, o);
        const float rstd = rsqrtf(qq * (1.f / 1024.f) + LN_EPS);
        float* rp = P.out + row * D + lane * 8;
#pragma unroll
        for (int q = 0; q < 4; ++q) *(f32x4*)(rp + (q >> 1) * 512 + (q & 1) * 4) = v[q] * rstd * g4[q] + b4[q];
    }
}

#define XB_TMO      128
#define XB_XCNT(j)  (256  + 64 * (j))
#define XB_XSUB(j)  (1280 + 64 * (j))
#define XB_XGEN(j)  (2304 + 64 * (j))
#define XB_TOP      3328
#define XB_TOPGEN   3392
#define XCD_BAR_WORDS 3456
#define XB_SPIN_CAP (1u << 18)
#define LAS __attribute__((address_space(3)))

__device__ __forceinline__ unsigned xb_ld(unsigned* p)              { return __hip_atomic_load(p, __ATOMIC_RELAXED, __HIP_MEMORY_SCOPE_AGENT); }
__device__ __forceinline__ unsigned xb_add(unsigned* p, unsigned v) { return __hip_atomic_fetch_add(p, v, __ATOMIC_RELAXED, __HIP_MEMORY_SCOPE_AGENT); }
__device__ __forceinline__ unsigned xb_xcc_id() { return (unsigned)__builtin_amdgcn_s_getreg((3 << 11) | 20) & 0xFu; }
#define XB_SPIN(cond, bar) do { unsigned _sp = 0; while (cond) { __builtin_amdgcn_s_sleep(1); \
    if ((++_sp & 255u) == 0u) { if (xb_ld(&(bar)[XB_TMO])) break; if (_sp > XB_SPIN_CAP) { atomicAdd(&(bar)[XB_TMO], 1u); break; } } } } while (0)

struct XcdBarrier {
    unsigned* bar; unsigned x;
    volatile LAS unsigned* st;
};

__device__ __forceinline__ XcdBarrier xcd_barrier_post(unsigned* bar, volatile LAS unsigned* st) {
    XcdBarrier b; b.bar = bar; b.x = xb_xcc_id(); b.st = st;
    if (threadIdx.x == 0) (void)xb_add(&bar[XB_XCNT(b.x)], 1u);
    return b;
}
__device__ __forceinline__ void xcd_barrier_complete(unsigned* bar, unsigned x, unsigned& nloc, unsigned& nx) {
    const unsigned G = gridDim.x * gridDim.y * gridDim.z;
    unsigned sum, cnt, mine, sp = 0u;
    for (;;) {
        sum = 0u; cnt = 0u; mine = 0u;
#pragma unroll
        for (unsigned j = 0; j < 16; ++j) { const unsigned c = xb_ld(&bar[XB_XCNT(j)]); sum += c; cnt += (c > 0u) ? 1u : 0u; mine = (j == x) ? c : mine; }
        if (sum == G) break;
        __builtin_amdgcn_s_sleep(1);
        if ((++sp & 255u) == 0u) { if (xb_ld(&bar[XB_TMO])) break; if (sp > XB_SPIN_CAP) { atomicAdd(&bar[XB_TMO], 1u); break; } }
    }
    nloc = mine > 0u ? mine : 1u; nx = cnt > 0u ? cnt : 1u;
}

__device__ __forceinline__ void xcd_barrier(const XcdBarrier& b) {
    asm volatile("s_waitcnt vmcnt(0)" ::: "memory");
    __syncthreads();
    if (threadIdx.x == 0) {
        unsigned* bar = b.bar;
        __builtin_amdgcn_s_waitcnt(0);
        unsigned nloc = b.st[0], nx = b.st[1];
        if (nloc == 0u) { xcd_barrier_complete(bar, b.x, nloc, nx); b.st[0] = nloc; b.st[1] = nx; }
        const unsigned old = xb_add(&bar[XB_XSUB(b.x)], 1u);
        const unsigned gen = old / nloc;
        if (old + 1u == (gen + 1u) * nloc) {
            __builtin_amdgcn_fence(__ATOMIC_RELEASE, "agent");
            asm volatile("s_waitcnt vmcnt(0)" ::: "memory");
            const unsigned og = xb_add(&bar[XB_TOP], 1u);
            const unsigned tg = og / nx;
            if (og + 1u == (tg + 1u) * nx) xb_add(&bar[XB_TOPGEN], 1u);
            else XB_SPIN(xb_ld(&bar[XB_TOPGEN]) == tg, bar);
            __builtin_amdgcn_fence(__ATOMIC_ACQUIRE, "agent");
            xb_add(&bar[XB_XGEN(b.x)], 1u);
            asm volatile("s_waitcnt vmcnt(0)" ::: "memory");
        } else {
            XB_SPIN(xb_ld(&bar[XB_XGEN(b.x)]) == gen, bar);
            __builtin_amdgcn_fence(__ATOMIC_ACQUIRE, "agent");
            asm volatile("s_waitcnt vmcnt(0)" ::: "memory");
        }
    }
    __syncthreads();
}


constexpr int NPHASE = 8;
#ifndef PHM
#define PHM 511
#endif
#ifndef DBL
#define DBL 0
#endif
#define REP(bit) for (int _rep = 0; _rep < (((DBL) >> (bit)) & 1) + 1; ++_rep)
__global__ void __launch_bounds__(512, 2) mega(Params Pin) {
    extern __shared__ __attribute__((aligned(16))) unsigned char lds[];
    cg::grid_group grid = cg::this_grid();
    volatile LAS unsigned* xst = (volatile LAS unsigned*)(lds + XB_LDS_OFF);
    if (threadIdx.x < 4) xst[threadIdx.x] = 0u;
    __syncthreads();
    typedef const __attribute__((address_space(4))) Params* KP;
    const KP kp = (KP)__builtin_amdgcn_kernarg_segment_ptr();
    const int ph_lo = kp->phase_lo, ph_hi = kp->phase_hi;
    if (ph_lo < 0) grid.sync();
    const XcdBarrier xb = xcd_barrier_post(kp->xbar, xst);
#if defined(__HIP_DEVICE_COMPILE__)
#define LOADP() KP q = kp; asm volatile("" : "+s"(q)); const Params P = *q
#else
#define LOADP() const Params P = Pin
#endif
#define RUNS(ph) (ph_lo <= (ph) && (ph) < ph_hi)
#define SYNC_AFTER(ph) if (ph_lo <= (ph) && (ph) + 1 < ph_hi) xcd_barrier(xb)
    if (RUNS(0)) { LOADP(); if (PHM & 1) REP(5) { phase0(P, lds); __syncthreads(); } }
    SYNC_AFTER(0);
    if (RUNS(1)) { LOADP(); if (PHM & 2) REP(6) phase1(P); }
    SYNC_AFTER(1);
    if (RUNS(2)) { LOADP(); if (PHM & 4) REP(7) {
        pg8::Gemm g{P.hbf, P.wt_in, MTOK, NP, D}; pg8::StaticOrder S; S.init(MTOK, NP, (int)gridDim.x, (int)blockIdx.x, WGM_MAIN);
        pg8::EpiBf16<0> E{P.p, NP, nullptr, 0, 0};
        pg8::gemm_phase<pg8::EpiBf16<0>, pg8::StaticOrder, false>((PG8_LAS unsigned char*)lds, g, S, E, nullptr); } }
    SYNC_AFTER(2);
    if (RUNS(3)) { { LOADP(); if (PHM & 8) REP(0) phase3a(P, lds); } __syncthreads(); { LOADP(); if (PHM & 256) REP(1) { phaseF(P, lds); __syncthreads(); } } }
    SYNC_AFTER(3);
    if (RUNS(4)) { LOADP(); if (PHM & 16) REP(3) phase4s(P); }
    SYNC_AFTER(4);
    if (RUNS(5)) { LOADP(); if (PHM & 32) REP(4) phase5y(P); }
    SYNC_AFTER(5);
    if (RUNS(6)) { LOADP(); if (PHM & 64) REP(8) {
        pg8::Gemm g{P.hbf, P.wt_out, MTOK, D, D}; pg8::StaticOrder S; S.init(MTOK, D, (int)gridDim.x, (int)blockIdx.x, WGM_OUT);
        EpiOut E{P.pre, P.mod};
        pg8::gemm_phase<EpiOut, pg8::StaticOrder, false>((PG8_LAS unsigned char*)lds, g, S, E, nullptr); } }
    SYNC_AFTER(6);
    if (RUNS(7)) { LOADP(); if (PHM & 128) phase7(P); }
}

#ifndef MULTI_LAUNCH
#define MULTI_LAUNCH 0
#endif
extern "C" void kernel_launch(void* const* d_in, const int* in_sizes, int n_in, void* d_out, int out_size, void* d_ws, size_t ws_size, hipStream_t stream) {
    static int grid = 0;
    if (grid == 0) {
        int dev = 0, cus = 0, per_cu = 0;
        hipGetDevice(&dev); hipDeviceGetAttribute(&cus, hipDeviceAttributeMultiprocessorCount, dev);
        if (hipFuncSetAttribute((const void*)mega, hipFuncAttributeMaxDynamicSharedMemorySize, LDS_BYTES) != hipSuccess) fprintf(stderr, "kernel_launch: hipFuncSetAttribute failed\n");
        if (hipOccupancyMaxActiveBlocksPerMultiprocessor(&per_cu, (const void*)mega, 512, LDS_BYTES) != hipSuccess || per_cu < 1) { fprintf(stderr, "kernel_launch: occupancy query gave %d\n", per_cu); per_cu = 1; }
        (void)hipGetLastError();
        grid = cus * per_cu;
        fprintf(stderr, "kernel_launch: grid %d (%d CUs x %d)\n", grid, cus, per_cu);
    }
    Params P{};
    const float** pin = (const float**)&P.x;
    for (int i = 0; i < 22; ++i) pin[i] = (const float*)d_in[i];
    P.out = (float*)d_out;
    unsigned char* w = (unsigned char*)d_ws; size_t off = 0;
    auto take = [&](size_t bytes) { unsigned char* q = w + off; off += (bytes + 255) & ~(size_t)255; return q; };
    P.mod = (float*)take(8 * 3072 * 4);
    P.hbf = (bf16_t*)take((size_t)MTOK * D * 2);
    P.wt_in = (bf16_t*)take((size_t)NP * D * 2);
    P.wt_out = (bf16_t*)take((size_t)D * D * 2);
    P.wupT = (bf16_t*)take(512 * 64 * 2);
    P.aupT = (bf16_t*)take(512 * 64 * 2);
    P.p = (bf16_t*)take((size_t)MTOK * NP * 2);
    P.xbar = (unsigned*)take(XCD_BAR_WORDS * 4);
    P.gC = (float*)take((size_t)4096 * 64 * 4); P.bonus = (float*)take((size_t)MTOK * 8 * 4);
    const size_t AB = (size_t)MTOK * 512 * 2;
    P.sv = (bf16_t*)take(AB); P.sg = (bf16_t*)take(AB); P.An = (bf16_t*)take(AB); P.Bn = (bf16_t*)take(AB); P.Kn = (bf16_t*)take(AB); P.Rn = (bf16_t*)take(AB);
    {
        unsigned char* q = (unsigned char*)d_out; P.At = (bf16_t*)q; P.Bt = (bf16_t*)(q + AB); P.Kt = (bf16_t*)(q + 2 * AB); P.Vt = (bf16_t*)(q + 3 * AB);
    }
    P.y = (float*)d_out;
    P.pre = P.p;
    P.cS = (bf16_t*)d_out;
    P.cG = P.An; P.cR = P.Bn; P.cH = P.Kn; P.cY = P.Rn;
    if (off > ws_size) { fprintf(stderr, "kernel_launch: workspace too small (%zu > %zu)\n", off, ws_size); return; }
    if (hipMemsetAsync(P.xbar, 0, XCD_BAR_WORDS * 4, stream) != hipSuccess) fprintf(stderr, "kernel_launch: memset of the barrier words failed\n");
#if MULTI_LAUNCH
    for (int ph = 0; ph < NPHASE; ++ph) { P.phase_lo = ph; P.phase_hi = ph + 1; hipLaunchKernelGGL(mega, dim3(grid), dim3(512), LDS_BYTES, stream, P); }
#else
    P.phase_lo = 0; P.phase_hi = NPHASE;
    void* args[] = {&P};
    hipError_t e = hipLaunchCooperativeKernel((const void*)mega, dim3(grid), dim3(512), args, LDS_BYTES, stream);
    if (e != hipSuccess) fprintf(stderr, "kernel_launch: cooperative launch failed: %s (grid %d)\n", hipGetErrorString(e), grid);
#endif
}
```
